# Optimizing an MI355X kernel written in HIP

```python
import math
import jax, jax.numpy as jnp
from jax import lax
import numpy as np


D_MODEL = 1024
BATCH = 1
SEQ = 16384
DEPTH = 2
DEC_BATCH = 8
DEC_SEQ = 8192
PAST_LEN = 128

HEAD_DIM = 64
D_FF = 2816
RMS_EPS = 1e-6
ROPE_THETA = 10000.0
NEG_INF = -1e30
DILATED_GROUPS = ((128, 1), (512, 4), (2048, 16))
N_GROUPS_A = 3
HEADS_PER_GROUP_A = 8
QKV_A = 3 * N_GROUPS_A * HEADS_PER_GROUP_A * HEAD_DIM
OUT_A = HEADS_PER_GROUP_A * HEAD_DIM
Q_BLOCK = 128
HEADS_B = 16
QKV_B = 3 * HEADS_B * HEAD_DIM
OUT_B = HEADS_B * HEAD_DIM
GRID_W = 64
NA_ROWS_MAX = 8
NA_COLS = 16
N_LAYERS_A = (DEPTH + 1) // 2
N_LAYERS_B = DEPTH // 2

kernel_name = "hybrid_dilated_neighbourhood_encoder"


def rms_norm(x, g):
    xf = x.astype(jnp.float32)
    y = xf * lax.rsqrt(jnp.mean(xf * xf, axis=-1, keepdims=True) + RMS_EPS)
    return (y * g.astype(jnp.float32)).astype(x.dtype)


def swiglu_ffn(x, g, w_in, w_out):
    h = rms_norm(x, g) @ w_in
    gate, up = jnp.split(h, 2, axis=-1)
    return (jax.nn.silu(gate) * up) @ w_out


def rope(x):
    S = x.shape[1]
    half = HEAD_DIM // 2
    inv_freq = ROPE_THETA ** (-jnp.arange(half, dtype=jnp.float32) / half)
    ang = jnp.arange(S, dtype=jnp.float32)[:, None] * inv_freq[None, :]
    bshape = (1, S) + (1,) * (x.ndim - 3) + (half,)
    cos = jnp.cos(ang).reshape(bshape)
    sin = jnp.sin(ang).reshape(bshape)
    xf = x.astype(jnp.float32)
    x1, x2 = xf[..., :half], xf[..., half:]
    return jnp.concatenate([x1 * cos - x2 * sin, x2 * cos + x1 * sin], axis=-1).astype(x.dtype)


def dilated_window_attention(q, k, v, dilation, side):
    B, S, H, Dh = q.shape
    L = S // dilation
    qb = min(Q_BLOCK, L)
    nb = -(-L // qb)
    lq = nb * qb
    kb_len = qb + 2 * side

    def by_stride(a):
        return a.reshape(B, L, dilation, H, Dh).transpose(0, 2, 1, 3, 4)

    qs = jnp.pad(by_stride(q), ((0, 0), (0, 0), (0, lq - L), (0, 0), (0, 0)))
    qs = qs.reshape(B, dilation, nb, qb, H, Dh)
    pad_k = ((0, 0), (0, 0), (side, side + lq - L), (0, 0), (0, 0))
    ks = jnp.pad(by_stride(k), pad_k)
    vs = jnp.pad(by_stride(v), pad_k)
    idx = jnp.arange(nb)[:, None] * qb + jnp.arange(kb_len)[None, :]
    kb = ks[:, :, idx]
    vb = vs[:, :, idx]
    s = jnp.einsum('bdnqhe,bdnkhe->bdnhqk', qs, kb).astype(jnp.float32)
    qpos = jnp.arange(nb)[:, None, None] * qb + jnp.arange(qb)[None, :, None]
    kpos = jnp.arange(nb)[:, None, None] * qb + jnp.arange(kb_len)[None, None, :] - side
    valid = (kpos >= 0) & (kpos < L) & (jnp.abs(qpos - kpos) <= side)
    s = jnp.where(valid[None, None, :, None], s, NEG_INF)
    m = jnp.max(s, axis=-1, keepdims=True)
    p = jnp.exp(s - m)
    den = jnp.sum(p, axis=-1)
    o = jnp.einsum('bdnhqk,bdnkhe->bdnqhe', p, vb.astype(jnp.float32))
    o = o / jnp.swapaxes(den, 3, 4)[..., None]
    lse = jnp.swapaxes(m[..., 0] + jnp.log(den), 3, 4)

    def back(a):
        a = a.reshape((B, dilation, lq) + a.shape[4:])[:, :, :L]
        a = jnp.swapaxes(a, 1, 2)
        return a.reshape((B, S) + a.shape[3:])

    return back(o), back(lse)


def mixer_a(h, w_qkv, q_gain, k_gain, w_o):
    B, S, _ = h.shape
    scale = HEAD_DIM ** -0.5
    qkv = (h @ w_qkv).reshape(B, S, 3, N_GROUPS_A, HEADS_PER_GROUP_A, HEAD_DIM)
    q = rope(rms_norm(qkv[:, :, 0], q_gain)) * scale
    k = rope(rms_norm(qkv[:, :, 1], k_gain))
    v = qkv[:, :, 2]
    outs, lses = [], []
    for g, (window, dil) in enumerate(DILATED_GROUPS):
        o_g, lse_g = dilated_window_attention(q[:, :, g], k[:, :, g], v[:, :, g], dil, window // (2 * dil))
        outs.append(o_g)
        lses.append(lse_g)
    weights = jax.nn.softmax(jnp.stack(lses), axis=0)
    o = jnp.sum(weights[..., None] * jnp.stack(outs), axis=0)
    return o.astype(h.dtype).reshape(B, S, OUT_A) @ w_o


def mixer_b(h, w_qkv, q_gain, k_gain, rpb, w_o):
    B, S, _ = h.shape
    rows = S // GRID_W
    kh = min(NA_ROWS_MAX, rows)
    scale = HEAD_DIM ** -0.5
    qkv = (h @ w_qkv).reshape(B, S, 3, HEADS_B, HEAD_DIM)
    qg = (rms_norm(qkv[:, :, 0], q_gain) * scale).reshape(B, rows, GRID_W, HEADS_B, HEAD_DIM)
    kg = rms_norm(qkv[:, :, 1], k_gain).reshape(B, rows, GRID_W, HEADS_B, HEAD_DIM)
    vg = qkv[:, :, 2].reshape(B, rows, GRID_W, HEADS_B, HEAD_DIM)
    row_start = jnp.clip(jnp.arange(rows) - kh // 2, 0, rows - kh)
    col = jnp.arange(GRID_W)
    col_start = jnp.clip(col - NA_COLS // 2, 0, GRID_W - NA_COLS)
    col_mask = (col[None, :] >= col_start[:, None]) & (col[None, :] < col_start[:, None] + NA_COLS)
    dc = jnp.clip(col[None, :] - col[:, None] + NA_COLS - 1, 0, 2 * NA_COLS - 2)

    def row_block(r):
        rs = row_start[r]
        q_r = lax.dynamic_index_in_dim(qg, r, axis=1, keepdims=False)
        k_r = lax.dynamic_slice_in_dim(kg, rs, kh, axis=1)
        v_r = lax.dynamic_slice_in_dim(vg, rs, kh, axis=1)
        s = jnp.einsum('bqhe,bjkhe->bhqjk', q_r, k_r).astype(jnp.float32)
        dr = rs + jnp.arange(kh) - r + NA_ROWS_MAX - 1
        bias = rpb[:, dr[None, :, None], dc[:, None, :]].astype(jnp.float32)
        s = jnp.where(col_mask[:, None, :], s + bias[None], NEG_INF)
        p = jax.nn.softmax(s.reshape(B, HEADS_B, GRID_W, kh * GRID_W), axis=-1).reshape(s.shape)
        return jnp.einsum('bhqjk,bjkhe->bqhe', p, v_r.astype(jnp.float32))

    o = lax.map(row_block, jnp.arange(rows))
    o = o.transpose(1, 0, 2, 3, 4).reshape(B, S, OUT_B).astype(h.dtype)
    return o @ w_o


def setup_inputs(seed: int = 0) -> dict:
    key = jax.random.key(seed)
    ks = jax.random.split(key, 20)
    f32 = jnp.float32

    def nrm(k, shape, fan_in):
        return jax.random.normal(k, shape, f32) * (fan_in ** -0.5)

    def gain(k, shape):
        return 1.0 + 0.02 * jax.random.normal(k, shape, f32)

    return {
        "x_prompt": jax.random.normal(ks[0], (BATCH, SEQ, D_MODEL), f32),
        "x_sample": jax.random.normal(ks[1], (DEC_BATCH, DEC_SEQ, D_MODEL), f32),
        "ffn1_norm": gain(ks[2], (DEPTH, D_MODEL)),
        "ffn1_w_in": nrm(ks[3], (DEPTH, D_MODEL, 2 * D_FF), D_MODEL),
        "ffn1_w_out": nrm(ks[4], (DEPTH, D_FF, D_MODEL), D_FF),
        "mix_norm": gain(ks[5], (DEPTH, D_MODEL)),
        "ffn2_norm": gain(ks[6], (DEPTH, D_MODEL)),
        "ffn2_w_in": nrm(ks[7], (DEPTH, D_MODEL, 2 * D_FF), D_MODEL),
        "ffn2_w_out": nrm(ks[8], (DEPTH, D_FF, D_MODEL), D_FF),
        "a_w_qkv": nrm(ks[9], (N_LAYERS_A, D_MODEL, QKV_A), D_MODEL),
        "a_q_norm": gain(ks[10], (N_LAYERS_A, HEAD_DIM)),
        "a_k_norm": gain(ks[11], (N_LAYERS_A, HEAD_DIM)),
        "a_w_o": nrm(ks[12], (N_LAYERS_A, OUT_A, D_MODEL), OUT_A),
        "b_w_qkv": nrm(ks[13], (N_LAYERS_B, D_MODEL, QKV_B), D_MODEL),
        "b_q_norm": gain(ks[14], (N_LAYERS_B, HEAD_DIM)),
        "b_k_norm": gain(ks[15], (N_LAYERS_B, HEAD_DIM)),
        "b_rpb": 0.1 * jax.random.normal(ks[16], (N_LAYERS_B, HEADS_B, 2 * NA_ROWS_MAX - 1, 2 * NA_COLS - 1), f32),
        "b_w_o": nrm(ks[17], (N_LAYERS_B, OUT_B, D_MODEL), OUT_B),
    }


def reference(x_prompt, x_sample, ffn1_norm, ffn1_w_in, ffn1_w_out, mix_norm, ffn2_norm, ffn2_w_in, ffn2_w_out,
              a_w_qkv, a_q_norm, a_k_norm, a_w_o, b_w_qkv, b_q_norm, b_k_norm, b_rpb, b_w_o):
    def trunk(x):
        for i in range(DEPTH):
            j = i // 2
            x = x + 0.5 * swiglu_ffn(x, ffn1_norm[i], ffn1_w_in[i], ffn1_w_out[i])
            h = rms_norm(x, mix_norm[i])
            if i % 2 == 0:
                x = x + mixer_a(h, a_w_qkv[j], a_q_norm[j], a_k_norm[j], a_w_o[j])
            else:
                x = x + mixer_b(h, b_w_qkv[j], b_q_norm[j], b_k_norm[j], b_rpb[j], b_w_o[j])
            x = x + 0.5 * swiglu_ffn(x, ffn2_norm[i], ffn2_w_in[i], ffn2_w_out[i])
        return x

    y_prompt = trunk(x_prompt)
    y_sample = trunk(x_sample)
    return (y_prompt, y_sample)
```

```cpp
#include <hip/hip_runtime.h>
#include <hip/hip_cooperative_groups.h>
#include <cstdio>
namespace cg = cooperative_groups;

#define LAS __attribute__((address_space(3)))
#define DI __device__ __forceinline__
typedef unsigned short bf16_t;
typedef short bf16x8 __attribute__((ext_vector_type(8)));
typedef float f32x4 __attribute__((ext_vector_type(4)));
typedef float f32x2 __attribute__((ext_vector_type(2)));
typedef float f32x16 __attribute__((ext_vector_type(16)));
typedef unsigned u32x4 __attribute__((ext_vector_type(4)));
typedef unsigned u32x2 __attribute__((ext_vector_type(2)));

constexpr int MTOK = 81920, DM = 1024, DFF = 2816, S0 = 16384, S1 = 8192;
constexpr int BM = 256, BK = 64, HALF = 128, HTB = HALF * BK * 2, STAGE_BYTES = 8 * HTB, NXCD = 8, WGM = 8;
constexpr int LDS_BYTES = 150016;
constexpr float RMS_EPS = 1e-6f;
#ifndef REP_ATT
#define REP_ATT 1
#endif
#ifndef REP_SWI
#define REP_SWI 1
#endif
#ifndef REP_FOUT
#define REP_FOUT 1
#endif
#ifndef REP_QKV
#define REP_QKV 1
#endif
#ifndef REP_PREP
#define REP_PREP 1
#endif

constexpr size_t MiB = 1024ull * 1024ull;
constexpr size_t OFF_WB = 0;
constexpr size_t OFF_XB = 84 * MiB;
constexpr size_t OFF_SSQ = 244 * MiB;
constexpr size_t OFF_COS = 249 * MiB;
constexpr size_t OFF_SIN = 251 * MiB;
constexpr size_t OFF_LSE = 253 * MiB;
constexpr size_t OFF_BAR = 1000 * MiB;
constexpr int XB_LDS_OFF = 150000;
constexpr int RS_OFF = 131072;
constexpr size_t OFF_BIG = 258 * MiB;
constexpr size_t WIN_SZ = (size_t)1024 * 5632, WOUT_SZ = (size_t)2816 * 1024;
constexpr size_t W_IN0 = 0, W_OUT0 = 4 * WIN_SZ, W_AQKV = W_OUT0 + 4 * WOUT_SZ, W_AWO = W_AQKV + (size_t)1024 * 4608,
                 W_BQKV = W_AWO + (size_t)512 * 1024, W_BWO = W_BQKV + (size_t)1024 * 3072;

struct Params {
    const float* in[18];
    float* x;
    unsigned char* ws;
};

__constant__ double c_inv_freq[32] = {
    1.0, 0.7498942093324559, 0.5623413251903491, 0.4216965034285822,
    0.31622776601683794, 0.23713737056616552, 0.1778279410038923, 0.1333521432163324,
    0.1, 0.07498942093324558, 0.05623413251903491, 0.042169650342858224,
    0.03162277660168379, 0.023713737056616554, 0.01778279410038923, 0.01333521432163324,
    0.01, 0.007498942093324558, 0.005623413251903491, 0.004216965034285823,
    0.0031622776601683794, 0.0023713737056616554, 0.0017782794100389228, 0.001333521432163324,
    0.001, 0.0007498942093324559, 0.0005623413251903491, 0.00042169650342858224,
    0.00031622776601683794, 0.00023713737056616554, 0.00017782794100389227, 0.0001333521432163324};

DI unsigned pk_bf16(float lo, float hi) { unsigned r; asm("v_cvt_pk_bf16_f32 %0, %1, %2" : "=v"(r) : "v"(lo), "v"(hi)); return r; }
DI unsigned pk_bf16_nop(float lo, float hi) { unsigned r; asm volatile("v_cvt_pk_bf16_f32 %0, %1, %2\n\ts_nop 1" : "=v"(r) : "v"(lo), "v"(hi)); return r; }
DI float bf_lo(unsigned w) { return __uint_as_float(w << 16); }
DI float bf_hi(unsigned w) { return __uint_as_float(w & 0xffff0000u); }

DI int lds_byte(int r, int c) { const int st = (r >> 4) * 2 + (c >> 5), rr = r & 15, cc = c & 31, ob = rr * 64 + cc * 2; return st * 1024 + (ob ^ (((ob >> 9) & 1) << 5)); }
DI void stage_rc(int b, int& R, int& C) { const int st = b / 1024, sb = b % 1024, swz = sb ^ (((sb >> 9) & 1) << 5); R = (st >> 1) * 16 + swz / 64; C = (st & 1) * 32 + (swz % 64) / 2; }
DI int perm32(int rho) { const int n = rho >> 4, i = rho & 15; return 8 * (i >> 2) + 4 * n + (i & 3); }

struct Unit { int pm, pn; };
struct AMap { const char* base; unsigned pitch; };

template <int NT> struct StaticOrderT {
    static constexpr int nM = MTOK / BM, nN = NT, nwg = nM * nN;
    int G, c, rev;
    DI void init(int G_, int c_, int rev_) { G = G_; c = c_; rev = rev_; }
    DI bool next(int i, Unit& u) const {
        const long L = (long)i * G + c; if (L >= nwg) return false;
        int wgid = (int)L; { const int q = nwg / NXCD, r = nwg % NXCD, xcd = wgid % NXCD, off = wgid / NXCD; wgid = (xcd < r ? xcd * (q + 1) : r * (q + 1) + (xcd - r) * q) + off; }
        constexpr int nig = WGM * nN; static_assert(nM % WGM == 0, "row tiles divide into full groups");
        const int gid = wgid / nig, fm = gid * WGM, rem = wgid - gid * nig;
        u.pm = fm + (rem % WGM); u.pn = rem / WGM; if (rev) u.pm = nM - 1 - u.pm; return true;
    }
};

DI void seq_of(int row, int& base, int& S) { if (row < S0) { base = 0; S = S0; } else { base = S0 + ((row - S0) & ~(S1 - 1)); S = S1; } }

DI void rstd8(const LAS unsigned char* rsl, int rl0, int fq, float (&rs)[8]) {
    f32x4 pp[8];
#pragma unroll
    for (int i = 0; i < 8; ++i) pp[i] = *(const LAS f32x4*)(rsl + (rl0 + (i >> 2) * HALF + (i & 3) * 16) * 64 + 16 * fq);
#pragma unroll
    for (int i = 0; i < 8; ++i) { float ss = (pp[i].x + pp[i].y) + (pp[i].z + pp[i].w); ss += __shfl_xor(ss, 16); ss += __shfl_xor(ss, 32); rs[i] = rsqrtf(ss * (1.0f / 1024.0f) + RMS_EPS); }
}

#ifndef REP_EPI_SWI
#define REP_EPI_SWI 1
#endif
struct EpiSwiglu {
    const bf16_t* A; bf16_t* H; const float* ssq;
    DI int nrep() const { return REP_EPI_SWI; }
    static constexpr bool NEEDS_RSTD = true; DI const char* ssq_base(const Unit& u, unsigned& pitch) const { pitch = 64u; return (const char*)(ssq + (size_t)(u.pm * BM) * 16); }
    DI AMap amap(const Unit& u) const { AMap a; a.base = (const char*)A + (size_t)u.pm * BM * DM * 2; a.pitch = DM * 2u; return a; }
    DI size_t kstepA() const { return 128; }
    DI void operator()(const f32x4 (&acc)[2][2][4][2], const Unit& u, int wr, int wc, int fr, int fq, const LAS unsigned char* rsl) const {
        const int row0 = u.pm * BM + wr * 64 + fr;
        float rs[8]; rstd8(rsl, wr * 64 + fr, fq, rs);
        bf16_t* hp = H + ((size_t)(u.pm * (DFF / 64) + 2 * u.pn + (wc >> 1)) * 256 + (wr * 64 + fr)) * 64 + (wc & 1) * 32 + 8 * fq;
#pragma unroll
        for (int ai = 0; ai < 2; ++ai)
#pragma unroll
            for (int m = 0; m < 4; ++m) {
                const float rstd = rs[4 * ai + m], c1 = -1.4426950408889634f * rstd, r2 = rstd * rstd;
                const f32x2 c1v = (f32x2){c1, c1}, r2v = (f32x2){r2, r2}, onev = (f32x2){1.0f, 1.0f};
                float hv[8];
#pragma unroll
                for (int n = 0; n < 2; ++n) {
                    const f32x4 A4 = acc[ai][0][m][n], B4 = acc[ai][1][m][n];
#pragma unroll
                    for (int hp = 0; hp < 2; ++hp) {
                        const f32x2 a = hp ? __builtin_shufflevector(A4, A4, 2, 3) : __builtin_shufflevector(A4, A4, 0, 1);
                        const f32x2 b = hp ? __builtin_shufflevector(B4, B4, 2, 3) : __builtin_shufflevector(B4, B4, 0, 1);
                        const f32x2 t = a * c1v;
                        f32x2 ex; ex.x = __builtin_amdgcn_exp2f(t.x); ex.y = __builtin_amdgcn_exp2f(t.y);
                        const f32x2 d = ex + onev;
                        f32x2 r; r.x = __builtin_amdgcn_rcpf(d.x); r.y = __builtin_amdgcn_rcpf(d.y);
                        const f32x2 h = (a * b) * (r * r2v);
                        hv[4 * n + 2 * hp] = h.x; hv[4 * n + 2 * hp + 1] = h.y;
                    }
                }
                u32x4 w; w.x = pk_bf16(hv[0], hv[1]); w.y = pk_bf16(hv[2], hv[3]); w.z = pk_bf16(hv[4], hv[5]); w.w = pk_bf16(hv[6], hv[7]);
                *(u32x4*)(hp + (size_t)(ai * HALF + m * 16) * 64) = w;
            }
    }
};

struct EpiResid {
    const bf16_t* A; int K; float* xout; bf16_t* xb; float* ssq; float alpha; int final;
    DI int nrep() const { return 1; }
    static constexpr bool NEEDS_RSTD = false; DI const char* ssq_base(const Unit&, unsigned& pitch) const { pitch = 0u; return nullptr; }
    int blocked;
    DI AMap amap(const Unit& u) const { AMap a; a.base = (const char*)A + (size_t)u.pm * BM * K * 2; a.pitch = blocked ? 128u : (unsigned)K * 2u; return a; }
    DI size_t kstepA() const { return blocked ? 32768 : 128; }
    DI void operator()(const f32x4 (&acc)[2][2][4][2], const Unit& u, int wr, int wc, int fr, int fq, const LAS unsigned char* rsl) const {
        const int col0 = u.pn * BM + wc * 32 + 8 * fq, row0 = u.pm * BM + wr * 64 + fr;
        bf16_t* b0 = xb + (size_t)row0 * DM + col0;
        u32x4 cur[2], nx[2];
        cur[0] = *(const u32x4*)(b0); cur[1] = *(const u32x4*)(b0 + HALF);
#pragma unroll
        for (int idx = 0; idx < 8; ++idx) {
            const int ai = idx >> 2, m = idx & 3;
            if (idx < 7) { const bf16_t* nb = b0 + (size_t)(((idx + 1) >> 2) * HALF + ((idx + 1) & 3) * 16) * DM; nx[0] = *(const u32x4*)(nb); nx[1] = *(const u32x4*)(nb + HALF); }
            asm volatile("" ::: "memory");
            const int row = row0 + ai * HALF + m * 16;
            bf16_t* br = b0 + (size_t)(ai * HALF + m * 16) * DM;
            float part = 0.f;
#pragma unroll
            for (int bj = 0; bj < 2; ++bj) {
                const u32x4 xo = cur[bj];
                f32x4 o0 = (f32x4){bf_lo(xo.x), bf_hi(xo.x), bf_lo(xo.y), bf_hi(xo.y)}, o1 = (f32x4){bf_lo(xo.z), bf_hi(xo.z), bf_lo(xo.w), bf_hi(xo.w)};
                o0 += alpha * acc[ai][bj][m][0]; o1 += alpha * acc[ai][bj][m][1];
                if (final) { float* xr = xout + (size_t)row * DM + col0 + bj * HALF; *(f32x4*)(xr) = o0; *(f32x4*)(xr + 4) = o1; }
                else {
                    part += (o0.x * o0.x + o0.y * o0.y) + (o0.z * o0.z + o0.w * o0.w) + (o1.x * o1.x + o1.y * o1.y) + (o1.z * o1.z + o1.w * o1.w);
                    u32x4 w; w.x = pk_bf16(o0.x, o0.y); w.y = pk_bf16(o0.z, o0.w); w.z = pk_bf16(o1.x, o1.y); w.w = pk_bf16(o1.z, o1.w);
                    *(u32x4*)(br + bj * HALF) = w;
                }
            }
            if (!final) { part += __shfl_xor(part, 16); part += __shfl_xor(part, 32);
                if (fq == 0) ssq[(size_t)row * 16 + u.pn * 4 + wc] = part; }
            if (idx < 7) { cur[0] = nx[0]; cur[1] = nx[1]; }
            asm volatile("" ::: "memory");
        }
    }
};

template <bool MIXA> struct EpiQkv {
    const bf16_t* A; const float* ssq; const float* qgain; const float* kgain; const float* cosT; const float* sinT;
    bf16_t* Q; bf16_t* Kk; bf16_t* VT;
    DI int nrep() const { return 1; }
    static constexpr bool NEEDS_RSTD = true; DI const char* ssq_base(const Unit& u, unsigned& pitch) const { int t0, d, p0; geom(u, t0, d, p0); pitch = 64u * (unsigned)d; return (const char*)(ssq + (size_t)t0 * 16); }
    DI void geom(const Unit& u, int& tokrow0, int& d, int& pos0) const {
        if (MIXA) {
            const int g = (u.pn % 6) >> 1, sh = 2 * g; int base, S; seq_of(u.pm * BM, base, S);
            const int lgL = (S == S0 ? 14 : 13) - sh, off = u.pm * BM - base, r = off >> lgL, m0 = off - (r << lgL);
            d = 1 << sh; pos0 = m0 * d + r; tokrow0 = base + pos0;
        } else { d = 1; tokrow0 = u.pm * BM; pos0 = 0; }
    }
    DI AMap amap(const Unit& u) const { int t0, d, p0; geom(u, t0, d, p0); AMap a; a.base = (const char*)A + (size_t)t0 * DM * 2; a.pitch = (unsigned)d * (DM * 2u); return a; }
    DI size_t kstepA() const { return 128; }
    DI void operator()(const f32x4 (&acc)[2][2][4][2], const Unit& u, int wr, int wc, int fr, int fq, const LAS unsigned char* rsl) const {
        int tok0, d, pos0; geom(u, tok0, d, pos0);
        const int t = MIXA ? u.pn / 6 : u.pn / 4;
        const int g = MIXA ? (u.pn % 6) >> 1 : 0;
        const int head = MIXA ? 4 * (u.pn & 1) + wc : 4 * (u.pn & 3) + wc;
        constexpr int HD = MIXA ? 512 : 1024;
        const int i0 = wr * 64 + fr;
        float rs[8]; rstd8(rsl, i0, fq, rs);
        if (t < 2) {
            const float* gn = t == 0 ? qgain : kgain;
            f32x4 gv[2][2];
#pragma unroll
            for (int bj = 0; bj < 2; ++bj)
#pragma unroll
                for (int n = 0; n < 2; ++n) gv[bj][n] = *(const f32x4*)(gn + 32 * bj + 8 * fq + 4 * n);
            bf16_t* dst = (t == 0 ? Q : Kk) + (size_t)g * MTOK * HD + (size_t)(u.pm * BM + i0) * HD + head * 64 + 8 * fq;
            const float sc = t == 0 ? 0.125f * 1.4426950408889634f : 1.0f;
            const float* cp = cosT + (size_t)(pos0 + i0 * d) * 32 + 8 * fq; const float* sp = sinT + (size_t)(pos0 + i0 * d) * 32 + 8 * fq;
            f32x4 cc[2], sn[2], ncc[2], nsn[2];
            if (MIXA) { cc[0] = *(const f32x4*)(cp); cc[1] = *(const f32x4*)(cp + 4); sn[0] = *(const f32x4*)(sp); sn[1] = *(const f32x4*)(sp + 4); }
#pragma unroll
            for (int idx = 0; idx < 8; ++idx) {
                const int ai = idx >> 2, m = idx & 3, il = ai * HALF + m * 16;
                if (MIXA && idx < 7) { const size_t o = (size_t)((((idx + 1) >> 2) * HALF + ((idx + 1) & 3) * 16) * d) * 32;
                    ncc[0] = *(const f32x4*)(cp + o); ncc[1] = *(const f32x4*)(cp + o + 4); nsn[0] = *(const f32x4*)(sp + o); nsn[1] = *(const f32x4*)(sp + o + 4); }
                asm volatile("" ::: "memory");
                const float rstd = rs[idx];
                f32x4 v[2][2]; float ss = 0.f;
#pragma unroll
                for (int bj = 0; bj < 2; ++bj)
#pragma unroll
                    for (int n = 0; n < 2; ++n) { v[bj][n] = acc[ai][bj][m][n] * rstd; const f32x4 q2 = v[bj][n] * v[bj][n]; ss += (q2.x + q2.y) + (q2.z + q2.w); }
                ss += __shfl_xor(ss, 16); ss += __shfl_xor(ss, 32);
                const float rn = rsqrtf(ss * (1.0f / 64.0f) + RMS_EPS) * sc;
#pragma unroll
                for (int bj = 0; bj < 2; ++bj)
#pragma unroll
                    for (int n = 0; n < 2; ++n) v[bj][n] = v[bj][n] * rn * gv[bj][n];
                if (MIXA) {
#pragma unroll
                    for (int n = 0; n < 2; ++n) { const f32x4 a = v[0][n], b = v[1][n]; v[0][n] = a * cc[n] - b * sn[n]; v[1][n] = b * cc[n] + a * sn[n]; }
                }
                bf16_t* rp = dst + (size_t)il * HD;
#pragma unroll
                for (int bj = 0; bj < 2; ++bj) {
                    u32x4 w; w.x = pk_bf16(v[bj][0].x, v[bj][0].y); w.y = pk_bf16(v[bj][0].z, v[bj][0].w); w.z = pk_bf16(v[bj][1].x, v[bj][1].y); w.w = pk_bf16(v[bj][1].z, v[bj][1].w);
                    *(u32x4*)(rp + 32 * bj) = w;
                }
                if (MIXA && idx < 7) { cc[0] = ncc[0]; cc[1] = ncc[1]; sn[0] = nsn[0]; sn[1] = nsn[1]; }
                asm volatile("" ::: "memory");
            }
        } else {
            bf16_t* dst = VT + (size_t)g * MTOK * HD + (size_t)(u.pm * BM + i0) * HD + head * 64 + 8 * fq;
#pragma unroll
            for (int ai = 0; ai < 2; ++ai)
#pragma unroll
                for (int m = 0; m < 4; ++m) {
                    const float rstd = rs[4 * ai + m];
                    bf16_t* rp = dst + (size_t)(ai * HALF + m * 16) * HD;
#pragma unroll
                    for (int bj = 0; bj < 2; ++bj) {
                        const f32x4 v0 = acc[ai][bj][m][0] * rstd, v1 = acc[ai][bj][m][1] * rstd;
                        u32x4 w; w.x = pk_bf16(v0.x, v0.y); w.y = pk_bf16(v0.z, v0.w); w.z = pk_bf16(v1.x, v1.y); w.w = pk_bf16(v1.z, v1.w);
                        *(u32x4*)(rp + 32 * bj) = w;
                    }
                }
        }
    }
};

template <int N, int K, class Epi>
__device__ __forceinline__ void gemm_phase(LAS unsigned char* lds, const bf16_t* Btp, const Epi& E, int rev, int vb) {
    int tid = threadIdx.x; asm volatile("" : "+v"(tid));
    const int wid = __builtin_amdgcn_readfirstlane(tid >> 6), lane = tid & 63, wr = wid >> 2, wc = wid & 3, fr = lane & 15, fq = lane >> 4;
    const int nt = K / BK;
    unsigned voAr, voAc, voffB;
    { int R, C; stage_rc(tid * 16, R, C); const int Rb = (R & ~31) + perm32(R & 31);
      voAr = (unsigned)R; voAc = (unsigned)C * 2u; voffB = (unsigned)(Rb * K + C) * 2u; }
    const size_t kstepA = E.kstepA();
    const size_t kstep = (size_t)(BK * 2);
    const size_t hstepB = (size_t)HALF * K * 2;
    const size_t tstepB = 2 * hstepB;
    const size_t qstepB = hstepB >> 1;
    const unsigned ldsw = (unsigned)wid * 1024u;
    const int aoff = lds_byte(wr * 64 + fr, fq * 8), boff = lds_byte(wc * 32 + fr, fq * 8);
#define G_SA(b, h) (((b) * 2 + (h)) * HTB)
#define G_SB(b, h) ((4 + (b) * 2 + (h)) * HTB)
#define G_STAGE(bufoff, gbase, voff, q64) do { _Pragma("unroll") for (int _i = 0; _i < 2; ++_i) \
        __builtin_amdgcn_global_load_lds((const unsigned*)((const char*)(gbase) + (size_t)_i * (q64) + (voff)), (LAS unsigned*)(lds + (bufoff) + ldsw + _i * 8192), 16, 0, 0); } while (0)
#define G_STB(bufoff, gbase) G_STAGE(bufoff, gbase, voffB, qstepB)
#define G_STA(bufoff, gbase, pitch) G_STAGE(bufoff, gbase, voAr * (pitch) + voAc, (size_t)64 * (pitch))
#define G_LDA(dst, b, h) do { _Pragma("unroll") for (int m = 0; m < 4; ++m) _Pragma("unroll") for (int k = 0; k < 2; ++k) dst[m][k] = *(const LAS bf16x8*)(lds + G_SA(b, h) + aoff + m * 2048 + k * 1024); } while (0)
#define G_LDB(dst, b, h) do { _Pragma("unroll") for (int n = 0; n < 2; ++n) _Pragma("unroll") for (int k = 0; k < 2; ++k) dst[n][k] = *(const LAS bf16x8*)(lds + G_SB(b, h) + boff + n * 2048 + k * 1024); } while (0)
#define G_MMA(ai, bj, At, Bt) do { __builtin_amdgcn_s_setprio(1); _Pragma("unroll") for (int m = 0; m < 4; ++m) _Pragma("unroll") for (int n = 0; n < 2; ++n) _Pragma("unroll") for (int k = 0; k < 2; ++k) \
        acc[ai][bj][m][n] = __builtin_amdgcn_mfma_f32_16x16x32_bf16(Bt[n][k], At[m][k], acc[ai][bj][m][n], 0, 0, 0); __builtin_amdgcn_s_setprio(0); } while (0)
#define G_WAIT_V(n) asm volatile("s_waitcnt vmcnt(" #n ")" ::: "memory")
#define G_WAIT_L(n) asm volatile("s_waitcnt lgkmcnt(" #n ")" ::: "memory")
#define G_BAR __builtin_amdgcn_s_barrier()
#define G_SCHED __builtin_amdgcn_sched_barrier(0)
    StaticOrderT<N / BM> S; S.init((int)gridDim.x, vb, rev);
    Unit cur, nxt; int ui = 0;
    if (!S.next(0, cur)) return;
    f32x4 acc[2][2][4][2];
#pragma unroll
    for (int a = 0; a < 2; ++a)
#pragma unroll
        for (int b = 0; b < 2; ++b)
#pragma unroll
            for (int m = 0; m < 4; ++m)
#pragma unroll
                for (int n = 0; n < 2; ++n) acc[a][b][m][n] = (f32x4){0.f, 0.f, 0.f, 0.f};
    bf16x8 At[4][2], B0[2][2], B1[2][2];
    AMap am = E.amap(cur);
    const char* cA = am.base; const char* cB = (const char*)Btp + (size_t)cur.pn * tstepB;
    unsigned mulA = am.pitch;
    G_STB(G_SB(0, 0), cB); G_STA(G_SA(0, 0), cA, mulA); G_STB(G_SB(0, 1), cB + hstepB); G_STA(G_SA(0, 1), cA + (size_t)HALF * mulA, mulA);
    if (wr == 1) G_BAR;
    G_WAIT_V(4); G_BAR;
    G_STB(G_SB(1, 0), cB + kstep); G_STA(G_SA(1, 0), cA + kstepA, mulA); G_STB(G_SB(1, 1), cB + hstepB + kstep);
    G_WAIT_V(6); G_BAR;
    for (;;) {
        const bool has_next = S.next(ui + 1, nxt);
        AMap an; if (has_next) an = E.amap(nxt); else { an.base = cA; an.pitch = mulA; }
        const char* nA = an.base; const char* nB = has_next ? (const char*)Btp + (size_t)nxt.pn * tstepB : cB;
        const unsigned mulN = an.pitch;
        if (Epi::NEEDS_RSTD) {
            unsigned sp; const char* sb = E.ssq_base(cur, sp);
#pragma unroll
            for (int j = 0; j < 2; ++j) { const int k = 2 * wc + j, rb = (k >> 2) * HALF + wr * 64 + (k & 3) * 16; const unsigned vo = (unsigned)(lane >> 2) * sp + (unsigned)(lane & 3) * 16u;
                __builtin_amdgcn_global_load_lds((const unsigned*)(sb + (size_t)rb * sp + vo), (LAS unsigned*)(lds + RS_OFF + (rb >> 4) * 1024), 16, 0, 0); }
        }
        _Pragma("nounroll") for (int t = 0; t < nt; t += 2) {
            const bool last = (t == nt - 2);
            const char* a1 = cA + (size_t)(t + 1) * kstepA;
            const char* a2 = last ? nA : cA + (size_t)(t + 2) * kstepA; const char* b2 = last ? nB : cB + (size_t)(t + 2) * kstep;
            const char* a3 = a2 + kstepA; const char* b3 = b2 + kstep;
            const unsigned mul2 = last ? mulN : mulA;
            G_LDB(B0, 0, 0); G_SCHED; G_LDA(At, 0, 0); G_STA(G_SA(1, 1), a1 + (size_t)HALF * mulA, mulA);
            G_WAIT_L(8); G_BAR; G_WAIT_L(0); G_MMA(0, 0, At, B0); G_BAR; G_SCHED;
            G_LDB(B1, 0, 1); G_STB(G_SB(0, 0), b2);
            G_BAR; G_WAIT_L(0); G_MMA(0, 1, At, B1); G_BAR;
            G_LDA(At, 0, 1); G_STA(G_SA(0, 0), a2, mul2);
            G_BAR; G_WAIT_L(0); G_MMA(1, 0, At, B0); G_BAR; G_SCHED;
            G_STB(G_SB(0, 1), b2 + hstepB);
            G_WAIT_V(6); G_BAR; G_MMA(1, 1, At, B1); G_BAR;
            G_LDB(B0, 1, 0); G_SCHED; G_LDA(At, 1, 0); G_STA(G_SA(0, 1), a2 + (size_t)HALF * mul2, mul2);
            G_WAIT_L(8); G_BAR; G_WAIT_L(0); G_MMA(0, 0, At, B0); G_BAR; G_SCHED;
            G_LDB(B1, 1, 1); G_STB(G_SB(1, 0), b3);
            G_BAR; G_WAIT_L(0); G_MMA(0, 1, At, B1); G_BAR;
            G_LDA(At, 1, 1); G_STA(G_SA(1, 0), a3, mul2);
            G_BAR; G_WAIT_L(0); G_MMA(1, 0, At, B0); G_BAR; G_SCHED;
            G_STB(G_SB(1, 1), b3 + hstepB);
            G_WAIT_V(6); G_BAR; G_MMA(1, 1, At, B1); G_BAR;
        }
        for (int rep_e = 0; rep_e < E.nrep(); ++rep_e) { E(acc, cur, wr, wc, fr, fq, lds + RS_OFF); asm volatile("" ::: "memory"); }
        if (!has_next) break;
        if (Epi::NEEDS_RSTD) { asm volatile("s_waitcnt lgkmcnt(0)" ::: "memory"); G_BAR; }
#pragma unroll
        for (int a = 0; a < 2; ++a)
#pragma unroll
            for (int b = 0; b < 2; ++b)
#pragma unroll
                for (int m = 0; m < 4; ++m)
#pragma unroll
                    for (int n = 0; n < 2; ++n) acc[a][b][m][n] = (f32x4){0.f, 0.f, 0.f, 0.f};
        cur = nxt; cA = nA; cB = nB; mulA = mulN; ++ui;
    }
    G_WAIT_V(0);
    if (wr == 0) G_BAR;
    G_BAR;
#undef G_SA
#undef G_SB
#undef G_STAGE
#undef G_STA
#undef G_STB
#undef G_LDA
#undef G_LDB
#undef G_MMA
}

DI int lmap(int kind, int p) {
    if (kind == 1) { const int pn = p >> 8, bj = (p >> 7) & 1, q = p & 127; return bj * DFF + pn * 128 + q; }
    if (kind == 2) { const int pn = p >> 8, bj = (p >> 7) & 1, wc = (p >> 5) & 3, j = p & 31; return pn * 256 + wc * 64 + bj * 32 + j; }
    return p;
}
DI void prep_weight_tile(const float* W, const float* gain, bf16_t* Bt, int K, int N, int kind, int tl, LAS float* T, int tid) {
    const int ntp = N >> 8, kt = tl / ntp, pt = tl - kt * ntp, k0 = kt * 64, p0 = pt * 256;
    { const int ty = tid >> 6, tx = tid & 63; float wv[4][8];
#pragma unroll
      for (int s = 0; s < 4; ++s) { const int Lc = lmap(kind, p0 + 64 * s + tx);
#pragma unroll
          for (int i = 0; i < 8; ++i) wv[s][i] = W[(size_t)(k0 + ty + 8 * i) * N + Lc]; }
      float gk[8];
#pragma unroll
      for (int i = 0; i < 8; ++i) gk[i] = gain ? gain[k0 + ty + 8 * i] : 1.0f;
#pragma unroll
      for (int s = 0; s < 4; ++s)
#pragma unroll
          for (int i = 0; i < 8; ++i) T[s * 4160 + (ty + 8 * i) * 65 + tx] = wv[s][i] * gk[i]; }
    __syncthreads();
    { const int py = tid >> 3, kx = tid & 7;
#pragma unroll
      for (int s = 0; s < 4; ++s) { const LAS float* Ts = T + s * 4160; u32x4 o;
          o.x = pk_bf16(Ts[(kx * 8 + 0) * 65 + py], Ts[(kx * 8 + 1) * 65 + py]); o.y = pk_bf16(Ts[(kx * 8 + 2) * 65 + py], Ts[(kx * 8 + 3) * 65 + py]);
          o.z = pk_bf16(Ts[(kx * 8 + 4) * 65 + py], Ts[(kx * 8 + 5) * 65 + py]); o.w = pk_bf16(Ts[(kx * 8 + 6) * 65 + py], Ts[(kx * 8 + 7) * 65 + py]);
          *(u32x4*)(Bt + (size_t)(p0 + 64 * s + py) * K + k0 + kx * 8) = o; } }
    __syncthreads();
}

__device__ __forceinline__ void phase_prep(const Params& p, LAS unsigned char* lds) {
    bf16_t* WB = (bf16_t*)(p.ws + OFF_WB);
    LAS float* T = (LAS float*)lds;
    int tid = threadIdx.x; asm volatile("" : "+v"(tid));
    for (int tile = blockIdx.x; tile < 2688; tile += gridDim.x) {
        const float* W; const float* gain = nullptr; bf16_t* Bt; int K, N, kind, tl;
        if (tile < 1408) { const int s = tile / 352; tl = tile - s * 352; K = 1024; N = 5632; kind = 1;
            W = ((s & 1) ? p.in[7] : p.in[3]) + (size_t)(s >> 1) * WIN_SZ; gain = ((s & 1) ? p.in[6] : p.in[2]) + (s >> 1) * 1024; Bt = WB + W_IN0 + (size_t)s * WIN_SZ; }
        else if (tile < 2112) { const int s = (tile - 1408) / 176; tl = (tile - 1408) - s * 176; K = 2816; N = 1024; kind = 0;
            W = ((s & 1) ? p.in[8] : p.in[4]) + (size_t)(s >> 1) * WOUT_SZ; Bt = WB + W_OUT0 + (size_t)s * WOUT_SZ; }
        else if (tile < 2400) { tl = tile - 2112; K = 1024; N = 4608; kind = 2; W = p.in[9]; gain = p.in[5]; Bt = WB + W_AQKV; }
        else if (tile < 2432) { tl = tile - 2400; K = 512; N = 1024; kind = 0; W = p.in[12]; Bt = WB + W_AWO; }
        else if (tile < 2624) { tl = tile - 2432; K = 1024; N = 3072; kind = 2; W = p.in[13]; gain = p.in[5] + 1024; Bt = WB + W_BQKV; }
        else { tl = tile - 2624; K = 1024; N = 1024; kind = 0; W = p.in[17]; Bt = WB + W_BWO; }
        prep_weight_tile(W, gain, Bt, K, N, kind, tl, T, tid);
    }
    { float* cosT = (float*)(p.ws + OFF_COS); float* sinT = (float*)(p.ws + OFF_SIN);
      for (int idx = blockIdx.x * 512 + tid; idx < S0 * 32; idx += gridDim.x * 512) {
          const int pos = idx >> 5, i = idx & 31;
          const double ang = (double)pos * c_inv_freq[i];
          double t = ang * 0.15915494309189535; t -= __builtin_rint(t);
          const float tf = (float)(2.0 * t);
          cosT[idx] = cospif(tf); sinT[idx] = sinpif(tf);
      } }
    { bf16_t* xb = (bf16_t*)(p.ws + OFF_XB); float* ssq = (float*)(p.ws + OFF_SSQ);
      const int lane = tid & 63, wid = tid >> 6;
      const int rstride = gridDim.x * 8;
      for (int row = blockIdx.x * 8 + wid; row < MTOK; row += 4 * rstride) {
          f32x4 v[4][4];
#pragma unroll
          for (int rr = 0; rr < 4; ++rr) { const int r2 = row + rr * rstride; if (r2 < MTOK) {
              const float* src = r2 < S0 ? p.in[0] + (size_t)r2 * DM : p.in[1] + (size_t)(r2 - S0) * DM;
#pragma unroll
              for (int j = 0; j < 4; ++j) v[rr][j] = *(const f32x4*)(src + 4 * lane + 256 * j); } }
#pragma unroll
          for (int rr = 0; rr < 4; ++rr) { const int r2 = row + rr * rstride; if (r2 < MTOK) {
              float ss = 0.f;
#pragma unroll
              for (int j = 0; j < 4; ++j) { const f32x4 q = v[rr][j] * v[rr][j]; ss += (q.x + q.y) + (q.z + q.w); }
#pragma unroll
              for (int o = 32; o >= 1; o >>= 1) ss += __shfl_xor(ss, o);
#pragma unroll
              for (int j = 0; j < 4; ++j) {
                  u32x2 w; w.x = pk_bf16(v[rr][j].x, v[rr][j].y); w.y = pk_bf16(v[rr][j].z, v[rr][j].w); *(u32x2*)(xb + (size_t)r2 * DM + 4 * lane + 256 * j) = w; }
              if (lane < 16) ssq[(size_t)r2 * 16 + lane] = lane == 0 ? ss : 0.f; } }
      } }
}

#define MFMA32(a, b, c) __builtin_amdgcn_mfma_f32_32x32x16_bf16((a), (b), (c), 0, 0, 0)
#define MFMA16(a, b, c) __builtin_amdgcn_mfma_f32_16x16x32_bf16((a), (b), (c), 0, 0, 0)
DI int crow(int reg, int h) { return (reg & 3) + 8 * (reg >> 2) + 4 * h; }

DI int kswz(int row, int ch) { return row * 128 + ((ch ^ ((row >> 1) & 7)) << 4); }
constexpr int AK_BYTES = 384 * 128;
constexpr int BK_BYTES = 576 * 128, BV_BYTES = 576 * 128;
DI int vswz_a(int row, int ch) { return row * 128 + ((ch ^ (((row >> 1) & 1) << 2)) << 4); }
DI int vswz_b(int row, int ch) { return row * 128 + (((((ch >> 1) ^ ((row >> 1) & 3)) << 1) | (ch & 1)) << 4); }
typedef short s16x4 __attribute__((ext_vector_type(4)));
DI u32x2 tr_read(const LAS unsigned char* p) { const s16x4 v = __builtin_amdgcn_ds_read_tr16_b64_v4i16((LAS s16x4*)p); return __builtin_bit_cast(u32x2, v); }
constexpr int B_RPB_OFF = BK_BYTES + BV_BYTES;

DI void attn_a_qload(const Params& p, int g, int head, int qb, int w, int lane, bf16x8 (&qf)[4]) {
    const bf16_t* Qg = (const bf16_t*)(p.ws + OFF_BIG) + (size_t)g * MTOK * 512;
    const int R0 = qb * 256 + 32 * w, q = lane & 31, hh = lane >> 5;
#pragma unroll
    for (int kk = 0; kk < 4; ++kk) qf[kk] = *(const bf16x8*)(Qg + (size_t)(R0 + q) * 512 + head * 64 + 16 * kk + 8 * hh);
}
DI void attn_a_prefetch(const Params& p, int g, int head, int qb, int tid, u32x4 (&kr)[6], u32x4 (&vr)[6]) {
    const bf16_t* Kg = (const bf16_t*)(p.ws + OFF_BIG + 240 * MiB) + (size_t)g * MTOK * 512 + head * 64;
    const bf16_t* Vg = (const bf16_t*)(p.ws + OFF_BIG + 480 * MiB) + (size_t)g * MTOK * 512 + head * 64;
    const int R0 = qb * 256;
#pragma unroll
    for (int i = 0; i < 6; ++i) { const int c = tid + 512 * i, row = c >> 3, ch = c & 7; int k = R0 - 64 + row; k = k < 0 ? 0 : (k > MTOK - 1 ? MTOK - 1 : k);
        kr[i] = *(const u32x4*)(Kg + (size_t)k * 512 + ch * 8); vr[i] = *(const u32x4*)(Vg + (size_t)k * 512 + ch * 8); }
}
DI void attn_a_stage(LAS unsigned char* lds, int tid, const u32x4 (&kr)[6], const u32x4 (&vr)[6]) {
#pragma unroll
    for (int i = 0; i < 6; ++i) { const int c = tid + 512 * i, row = c >> 3, ch = c & 7; *(LAS u32x4*)(lds + kswz(row, ch)) = kr[i]; *(LAS u32x4*)(lds + AK_BYTES + vswz_a(row, ch)) = vr[i]; }
}

template <bool MERGE>
__device__ __forceinline__ void attn_a_compute(const Params& p, const LAS unsigned char* lds, int g, int head, int qb, int w, int lane, const bf16x8 (&qf)[4]) {
    const int R0 = qb * 256 + 32 * w, q = lane & 31, hh = lane >> 5, sh = 2 * g, kl0 = 32 * w;
    int base, S; seq_of(R0, base, S);
    const int L = S >> sh, lo = base + ((R0 - base) & ~(L - 1)), hi = lo + L;
    f32x16 s[5];
#pragma unroll
    for (int kt = 0; kt < 5; ++kt) {
        bf16x8 kf[4];
#pragma unroll
        for (int kk = 0; kk < 4; ++kk) kf[kk] = *(const LAS bf16x8*)(lds + kswz(kl0 + 32 * kt + q, 2 * kk + hh));
#pragma unroll
        for (int i = 0; i < 16; ++i) s[kt][i] = 0.f;
#pragma unroll
        for (int kk = 0; kk < 4; ++kk) s[kt] = MFMA32(kf[kk], qf[kk], s[kt]);
    }
    const int qrow = R0 + q;
    float mx = -3.0e38f;
    if (R0 - 64 >= lo && R0 + 96 <= hi) {
        const int u = 4 * hh - q;
#pragma unroll
        for (int r = 0; r < 16; ++r) { const float v = (u >= -crow(r, 0)) ? s[0][r] : -1.0e30f; s[0][r] = v; mx = fmaxf(mx, v); }
#pragma unroll
        for (int kt = 1; kt < 4; ++kt)
#pragma unroll
            for (int r = 0; r < 16; ++r) mx = fmaxf(mx, s[kt][r]);
#pragma unroll
        for (int r = 0; r < 16; ++r) { const float v = (u <= -crow(r, 0)) ? s[4][r] : -1.0e30f; s[4][r] = v; mx = fmaxf(mx, v); }
    } else {
#pragma unroll
        for (int kt = 0; kt < 5; ++kt)
#pragma unroll
            for (int r = 0; r < 16; ++r) {
                const int key = R0 - 64 + 32 * kt + crow(r, hh); const int dd = key - qrow;
                const bool valid = key >= lo && key < hi && dd <= 64 && dd >= -64;
                const float v = valid ? s[kt][r] : -1.0e30f; s[kt][r] = v; mx = fmaxf(mx, v);
            }
    }
    mx = fmaxf(mx, __shfl_xor(mx, 32));
    float sum;
    { const f32x2 mxv = (f32x2){mx, mx}; f32x2 sum2 = (f32x2){0.f, 0.f};
#pragma unroll
      for (int kt = 0; kt < 5; ++kt)
#pragma unroll
          for (int r = 0; r < 16; r += 2) { const f32x2 d = (f32x2){s[kt][r], s[kt][r + 1]} - mxv; f32x2 e; e.x = __builtin_amdgcn_exp2f(d.x); e.y = __builtin_amdgcn_exp2f(d.y);
              s[kt][r] = e.x; s[kt][r + 1] = e.y; sum2 += e; }
      sum = sum2.x + sum2.y; }
    sum += __shfl_xor(sum, 32);
    f32x16 o[2];
#pragma unroll
    for (int i = 0; i < 16; ++i) { o[0][i] = 0.f; o[1][i] = 0.f; }
#pragma unroll
    for (int kt = 0; kt < 5; ++kt)
#pragma unroll
        for (int s2 = 0; s2 < 2; ++s2) {
            u32x4 pw;
            pw.x = pk_bf16_nop(s[kt][8 * s2 + 0], s[kt][8 * s2 + 1]); pw.y = pk_bf16_nop(s[kt][8 * s2 + 2], s[kt][8 * s2 + 3]);
            pw.z = pk_bf16_nop(s[kt][8 * s2 + 4], s[kt][8 * s2 + 5]); pw.w = pk_bf16_nop(s[kt][8 * s2 + 6], s[kt][8 * s2 + 7]);
            const bf16x8 pf = __builtin_bit_cast(bf16x8, pw);
            const int tq4 = (lane >> 2) & 3, tp4 = lane & 3, r0k = kl0 + 32 * kt + 16 * s2 + 4 * hh + tq4;
#pragma unroll
            for (int dt = 0; dt < 2; ++dt) {
                const int ch = 4 * dt + 2 * ((lane >> 4) & 1) + (tp4 >> 1);
                const u32x2 a = tr_read(lds + AK_BYTES + vswz_a(r0k, ch) + 8 * (tp4 & 1)), b = tr_read(lds + AK_BYTES + vswz_a(r0k + 8, ch) + 8 * (tp4 & 1));
                u32x4 vw; vw.x = a.x; vw.y = a.y; vw.z = b.x; vw.w = b.y;
                o[dt] = MFMA32(__builtin_bit_cast(bf16x8, vw), pf, o[dt]);
            }
        }
    const int lgL = (S == S0 ? 14 : 13) - sh, offq = qrow - base, rr = offq >> lgL, mm = offq - (rr << lgL), token = base + (mm << sh) + rr;
    const float inv = 1.0f / sum, lse = mx + __log2f(sum);
    if (!MERGE) {
        bf16_t* og = (bf16_t*)(p.x) + (size_t)(g - 1) * MTOK * 512 + (size_t)token * 512 + head * 64 + 4 * hh;
        float* lg = (float*)(p.ws + OFF_LSE) + (size_t)(g - 1) * MTOK * 8;
#pragma unroll
        for (int dt = 0; dt < 2; ++dt)
#pragma unroll
            for (int a = 0; a < 4; ++a) { u32x2 wv; wv.x = pk_bf16(o[dt][4 * a] * inv, o[dt][4 * a + 1] * inv); wv.y = pk_bf16(o[dt][4 * a + 2] * inv, o[dt][4 * a + 3] * inv);
                *(u32x2*)(og + 32 * dt + 8 * a) = wv; }
        if (hh == 0) lg[(size_t)token * 8 + head] = lse;
    } else {
        const float* lg = (const float*)(p.ws + OFF_LSE);
        const float l1 = lg[(size_t)token * 8 + head], l2 = lg[(size_t)MTOK * 8 + (size_t)token * 8 + head];
        const float m3 = fmaxf(lse, fmaxf(l1, l2));
        float w0 = __builtin_amdgcn_exp2f(lse - m3), w1 = __builtin_amdgcn_exp2f(l1 - m3), w2 = __builtin_amdgcn_exp2f(l2 - m3);
        const float wi = 1.0f / (w0 + w1 + w2); w0 *= wi * inv; w1 *= wi; w2 *= wi;
        const bf16_t* o1 = (const bf16_t*)(p.x) + (size_t)token * 512 + head * 64 + 4 * hh;
        const bf16_t* o2 = o1 + (size_t)MTOK * 512;
        bf16_t* of = (bf16_t*)(p.ws + OFF_BIG + 80 * MiB) + (size_t)token * 512 + head * 64 + 4 * hh;
#pragma unroll
        for (int dt = 0; dt < 2; ++dt)
#pragma unroll
            for (int a = 0; a < 4; ++a) {
                const u32x2 x1 = *(const u32x2*)(o1 + 32 * dt + 8 * a), x2 = *(const u32x2*)(o2 + 32 * dt + 8 * a);
                const float r0 = o[dt][4 * a] * w0 + bf_lo(x1.x) * w1 + bf_lo(x2.x) * w2, r1 = o[dt][4 * a + 1] * w0 + bf_hi(x1.x) * w1 + bf_hi(x2.x) * w2;
                const float r2 = o[dt][4 * a + 2] * w0 + bf_lo(x1.y) * w1 + bf_lo(x2.y) * w2, r3 = o[dt][4 * a + 3] * w0 + bf_hi(x1.y) * w1 + bf_hi(x2.y) * w2;
                u32x2 wv; wv.x = pk_bf16(r0, r1); wv.y = pk_bf16(r2, r3);
                *(u32x2*)(of + 32 * dt + 8 * a) = wv;
            }
    }
}

DI void attn_items(int vb, int nitems, int& it0, int& step, int& end) { const int G = (int)gridDim.x; if ((G & 7) || (nitems % G)) { it0 = vb; step = G; end = nitems; } else { it0 = (vb & 7) * (nitems >> 3) + (vb >> 3); step = G >> 3; end = it0 + (nitems / G) * step; } }
template <bool MERGE>
__device__ __forceinline__ void attn_a_phase(const Params& p, LAS unsigned char* lds, int g_lo, int n_g, int vb) {
    int tid = threadIdx.x; asm volatile("" : "+v"(tid));
    const int lane = tid & 63, w = __builtin_amdgcn_readfirstlane(tid >> 6);
    const int nitems = n_g * 8 * 320;
    u32x4 kr[6], vr[6]; bf16x8 qf[4], qn[4];
    int it, itstep, itend; attn_items(vb, nitems, it, itstep, itend);
    if (it < itend) { attn_a_prefetch(p, g_lo + it / 2560, (it % 2560) / 320, it % 320, tid, kr, vr); attn_a_qload(p, g_lo + it / 2560, (it % 2560) / 320, it % 320, w, lane, qf); }
    for (; it < itend; it += itstep) {
        __syncthreads();
        attn_a_stage(lds, tid, kr, vr);
        __syncthreads();
        const int nx = it + itstep;
        if (nx < itend) { attn_a_prefetch(p, g_lo + nx / 2560, (nx % 2560) / 320, nx % 320, tid, kr, vr); attn_a_qload(p, g_lo + nx / 2560, (nx % 2560) / 320, nx % 320, w, lane, qn); }
        attn_a_compute<MERGE>(p, lds, g_lo + it / 2560, (it % 2560) / 320, it % 320, w, lane, qf);
        if (nx < itend) {
#pragma unroll
            for (int kk = 0; kk < 4; ++kk) qf[kk] = qn[kk]; }
    }
    __syncthreads();
}

DI void attn_b_geom(int rp, int& base, int& rows, int& r0, int& krow0) {
    const int T0 = rp * 128; int S; seq_of(T0, base, S); rows = S >> 6; r0 = (T0 - base) >> 6;
    int rs = r0 - 4; rs = rs < 0 ? 0 : (rs > rows - 8 ? rows - 8 : rs); krow0 = rs;
}
DI void attn_b_qload(const Params& p, int head, int rp, int w, int lane, bf16x8 (&qf)[2]) {
    const bf16_t* Qb = (const bf16_t*)(p.ws + OFF_BIG);
    const int T0 = rp * 128 + 16 * w, q = lane & 15, qq = lane >> 4;
#pragma unroll
    for (int kk = 0; kk < 2; ++kk) qf[kk] = *(const bf16x8*)(Qb + (size_t)(T0 + q) * 1024 + head * 64 + 32 * kk + 8 * qq);
}
DI void attn_b_prefetch(const Params& p, int head, int rp, int tid, u32x4 (&kr)[9], u32x4 (&vr)[9]) {
    const bf16_t* Kb = (const bf16_t*)(p.ws + OFF_BIG + 160 * MiB) + head * 64;
    const bf16_t* Vb = (const bf16_t*)(p.ws + OFF_BIG + 320 * MiB) + head * 64;
    int base, rows, r0, krow0; attn_b_geom(rp, base, rows, r0, krow0);
#pragma unroll
    for (int i = 0; i < 9; ++i) { const int c = tid + 512 * i, kl = c >> 3, ch = c & 7; int gr = krow0 + (kl >> 6); gr = gr > rows - 1 ? rows - 1 : gr;
        const size_t o = (size_t)(base + gr * 64 + (kl & 63)) * 1024 + ch * 8;
        kr[i] = *(const u32x4*)(Kb + o); vr[i] = *(const u32x4*)(Vb + o); }
}
DI void attn_b_stage(LAS unsigned char* lds, int tid, const u32x4 (&kr)[9], const u32x4 (&vr)[9]) {
#pragma unroll
    for (int i = 0; i < 9; ++i) { const int c = tid + 512 * i, kl = c >> 3, ch = c & 7; *(LAS u32x4*)(lds + kswz(kl, ch)) = kr[i]; *(LAS u32x4*)(lds + BK_BYTES + vswz_b(kl, ch)) = vr[i]; }
}
__device__ __forceinline__ void attn_b_compute(const Params& p, const LAS unsigned char* lds, int head, int rp, int w, int lane, const bf16x8 (&qf)[2]) {
    bf16_t* Ob = (bf16_t*)(p.ws + OFF_BIG + 480 * MiB);
    const LAS float* rb = (const LAS float*)(lds + B_RPB_OFF);
    int base, rows, r0, krow0; attn_b_geom(rp, base, rows, r0, krow0);
    const int q = lane & 15, qq = lane >> 4;
    const int r = r0 + (w >> 2), c0 = 16 * (w & 3), T0 = base + r * 64 + c0;
    int rs = r - 4; rs = rs < 0 ? 0 : (rs > rows - 8 ? rows - 8 : rs);
    const int jl0 = rs - krow0;
    int kc0 = c0 - 8; kc0 = kc0 < 0 ? 0 : (kc0 > 32 ? 32 : kc0);
    const int c = c0 + q; int cs = c - 8; cs = cs < 0 ? 0 : (cs > 48 ? 48 : cs);
    f32x4 s[8][2];
#pragma unroll
    for (int j = 0; j < 8; ++j)
#pragma unroll
        for (int ct = 0; ct < 2; ++ct) {
            const int kl = (jl0 + j) * 64 + kc0 + 16 * ct + q;
            const bf16x8 k0 = *(const LAS bf16x8*)(lds + kswz(kl, qq)), k1 = *(const LAS bf16x8*)(lds + kswz(kl, 4 + qq));
            f32x4 z = (f32x4){0.f, 0.f, 0.f, 0.f};
            z = MFMA16(k0, qf[0], z); z = MFMA16(k1, qf[1], z);
            s[j][ct] = z;
        }
    float mx = -3.0e38f;
    const int uu = kc0 + 4 * qq - cs;
    const LAS float* rbl = rb + ((rs - r + 7) * 31 + (kc0 + 4 * qq - c + 15));
#pragma unroll
    for (int j = 0; j < 8; ++j)
#pragma unroll
        for (int ct = 0; ct < 2; ++ct)
#pragma unroll
            for (int e = 0; e < 4; ++e) {
                const bool valid = (unsigned)(uu + 16 * ct + e) < 16u;
                const float v = valid ? s[j][ct][e] + rbl[31 * j + 16 * ct + e] : -1.0e30f; s[j][ct][e] = v; mx = fmaxf(mx, v);
            }
    mx = fmaxf(mx, __shfl_xor(mx, 16)); mx = fmaxf(mx, __shfl_xor(mx, 32));
    float sum;
    { const f32x2 mxv = (f32x2){mx, mx}; f32x2 sum2 = (f32x2){0.f, 0.f};
#pragma unroll
      for (int j = 0; j < 8; ++j)
#pragma unroll
          for (int ct = 0; ct < 2; ++ct)
#pragma unroll
              for (int e = 0; e < 4; e += 2) { const f32x2 d = (f32x2){s[j][ct][e], s[j][ct][e + 1]} - mxv; f32x2 ex; ex.x = __builtin_amdgcn_exp2f(d.x); ex.y = __builtin_amdgcn_exp2f(d.y);
                  s[j][ct][e] = ex.x; s[j][ct][e + 1] = ex.y; sum2 += ex; }
      sum = sum2.x + sum2.y; }
    sum += __shfl_xor(sum, 16); sum += __shfl_xor(sum, 32);
    f32x4 o[4];
#pragma unroll
    for (int dt = 0; dt < 4; ++dt) o[dt] = (f32x4){0.f, 0.f, 0.f, 0.f};
#pragma unroll
    for (int j = 0; j < 8; ++j) {
        u32x4 pw; pw.x = pk_bf16_nop(s[j][0][0], s[j][0][1]); pw.y = pk_bf16_nop(s[j][0][2], s[j][0][3]); pw.z = pk_bf16_nop(s[j][1][0], s[j][1][1]); pw.w = pk_bf16_nop(s[j][1][2], s[j][1][3]);
        const bf16x8 pf = __builtin_bit_cast(bf16x8, pw);
        const int tq4 = (lane >> 2) & 3, tp4 = lane & 3, r0k = (jl0 + j) * 64 + kc0 + 4 * qq + tq4;
#pragma unroll
        for (int dt = 0; dt < 4; ++dt) {
            const int ch = 2 * dt + (tp4 >> 1);
            const u32x2 a = tr_read(lds + BK_BYTES + vswz_b(r0k, ch) + 8 * (tp4 & 1)), b = tr_read(lds + BK_BYTES + vswz_b(r0k + 16, ch) + 8 * (tp4 & 1));
            u32x4 vw; vw.x = a.x; vw.y = a.y; vw.z = b.x; vw.w = b.y;
            o[dt] = MFMA16(__builtin_bit_cast(bf16x8, vw), pf, o[dt]);
        }
    }
    const float inv = 1.0f / sum;
    bf16_t* op = Ob + (size_t)(T0 + q) * 1024 + head * 64 + 4 * qq;
#pragma unroll
    for (int dt = 0; dt < 4; ++dt) { u32x2 wv; wv.x = pk_bf16(o[dt].x * inv, o[dt].y * inv); wv.y = pk_bf16(o[dt].z * inv, o[dt].w * inv); *(u32x2*)(op + 16 * dt) = wv; }
}
__device__ __forceinline__ void attn_b_phase(const Params& p, LAS unsigned char* lds, int vb) {
    int tid = threadIdx.x; asm volatile("" : "+v"(tid));
    const int lane = tid & 63, w = __builtin_amdgcn_readfirstlane(tid >> 6);
    const int nitems = 16 * 640;
    u32x4 kr[9], vr[9]; bf16x8 qf[2], qn[2];
    int it, itstep, itend; attn_items(vb, nitems, it, itstep, itend);
    if (it < itend) { attn_b_prefetch(p, it / 640, it % 640, tid, kr, vr); attn_b_qload(p, it / 640, it % 640, w, lane, qf); }
    for (; it < itend; it += itstep) {
        const int head = it / 640;
        __syncthreads();
        attn_b_stage(lds, tid, kr, vr);
        if (tid < 465) ((LAS float*)(lds + B_RPB_OFF))[tid] = p.in[16][head * 465 + tid] * 1.4426950408889634f;
        __syncthreads();
        const int nx = it + itstep;
        if (nx < itend) { attn_b_prefetch(p, nx / 640, nx % 640, tid, kr, vr); attn_b_qload(p, nx / 640, nx % 640, w, lane, qn); }
        attn_b_compute(p, lds, head, it % 640, w, lane, qf);
        if (nx < itend) { qf[0] = qn[0]; qf[1] = qn[1]; }
    }
    __syncthreads();
}


#define XB_TMO      128
#define XB_XCNT(j)  (256  + 64 * (j))
#define XB_XSUB(j)  (1280 + 64 * (j))
#define XB_XGEN(j)  (2304 + 64 * (j))
#define XB_TOP      3328
#define XB_TOPGEN   3392
#define XCD_BAR_WORDS 3456
#define XB_SPIN_CAP (1u << 18)
__device__ __forceinline__ unsigned xb_ld(unsigned* p)              { return __hip_atomic_load(p, __ATOMIC_RELAXED, __HIP_MEMORY_SCOPE_AGENT); }
__device__ __forceinline__ unsigned xb_add(unsigned* p, unsigned v) { return __hip_atomic_fetch_add(p, v, __ATOMIC_RELAXED, __HIP_MEMORY_SCOPE_AGENT); }
__device__ __forceinline__ unsigned xb_xcc_id() { return (unsigned)__builtin_amdgcn_s_getreg((3 << 11) | 20) & 0xFu; }
#define XB_SPIN(cond, bar) do { unsigned _sp = 0; while (cond) { __builtin_amdgcn_s_sleep(1); \
    if ((++_sp & 255u) == 0u) { if (xb_ld(&(bar)[XB_TMO])) break; if (_sp > XB_SPIN_CAP) { atomicAdd(&(bar)[XB_TMO], 1u); break; } } } } while (0)
struct XcdBarrier { unsigned* bar; unsigned x; volatile LAS unsigned* st; };
__device__ __forceinline__ XcdBarrier xcd_barrier_post(unsigned* bar, volatile LAS unsigned* st) {
    XcdBarrier b; b.bar = bar; b.x = xb_xcc_id(); b.st = st;
    if (threadIdx.x == 0) st[2] = xb_add(&bar[XB_XCNT(b.x)], 1u);
    return b;
}
__device__ __forceinline__ void xcd_barrier_complete(unsigned* bar, unsigned x, unsigned& nloc, unsigned& nx) {
    const unsigned G = gridDim.x * gridDim.y * gridDim.z;
    unsigned sum, cnt, mine, sp = 0u;
    for (;;) {
        sum = 0u; cnt = 0u; mine = 0u;
#pragma unroll
        for (unsigned j = 0; j < 16; ++j) { const unsigned c = xb_ld(&bar[XB_XCNT(j)]); sum += c; cnt += (c > 0u) ? 1u : 0u; mine = (j == x) ? c : mine; }
        if (sum == G) break;
        __builtin_amdgcn_s_sleep(1);
        if ((++sp & 255u) == 0u) { if (xb_ld(&bar[XB_TMO])) break; if (sp > XB_SPIN_CAP) { atomicAdd(&bar[XB_TMO], 1u); break; } }
    }
    nloc = mine > 0u ? mine : 1u; nx = cnt > 0u ? cnt : 1u;
}
__device__ __forceinline__ void xcd_barrier(const XcdBarrier& b) {
    asm volatile("s_waitcnt vmcnt(0)" ::: "memory");
    __syncthreads();
    if (threadIdx.x == 0) {
        unsigned* bar = b.bar;
        __builtin_amdgcn_s_waitcnt(0);
        unsigned nloc = b.st[0], nx = b.st[1];
        if (nloc == 0u) { xcd_barrier_complete(bar, b.x, nloc, nx); b.st[0] = nloc; b.st[1] = nx; }
        const unsigned old = xb_add(&bar[XB_XSUB(b.x)], 1u);
        const unsigned gen = old / nloc;
        if (old + 1u == (gen + 1u) * nloc) {
            __builtin_amdgcn_fence(__ATOMIC_RELEASE, "agent");
            asm volatile("s_waitcnt vmcnt(0)" ::: "memory");
            const unsigned og = xb_add(&bar[XB_TOP], 1u);
            const unsigned tg = og / nx;
            if (og + 1u == (tg + 1u) * nx) xb_add(&bar[XB_TOPGEN], 1u);
            else XB_SPIN(xb_ld(&bar[XB_TOPGEN]) == tg, bar);
            __builtin_amdgcn_fence(__ATOMIC_ACQUIRE, "agent");
            xb_add(&bar[XB_XGEN(b.x)], 1u);
            asm volatile("s_waitcnt vmcnt(0)" ::: "memory");
        } else {
            XB_SPIN(xb_ld(&bar[XB_XGEN(b.x)]) == gen, bar);
            __builtin_amdgcn_fence(__ATOMIC_ACQUIRE, "agent");
            asm volatile("s_waitcnt vmcnt(0)" ::: "memory");
        }
    }
    __syncthreads();
}

__global__ void __launch_bounds__(512, 2) mega_kernel(Params p) {
    extern __shared__ __attribute__((aligned(16))) unsigned char shm[];
    LAS unsigned char* lds = (LAS unsigned char*)shm;
    cg::grid_group grid = cg::this_grid();
    bf16_t* WB = (bf16_t*)(p.ws + OFF_WB);
    bf16_t* xb = (bf16_t*)(p.ws + OFF_XB);
    float* ssq = (float*)(p.ws + OFF_SSQ);
    bf16_t* hbuf = (bf16_t*)(p.ws + OFF_BIG);
    const float* cosT = (const float*)(p.ws + OFF_COS); const float* sinT = (const float*)(p.ws + OFF_SIN);

    volatile LAS unsigned* xst = (volatile LAS unsigned*)(lds + XB_LDS_OFF);
    if (threadIdx.x == 0) { xst[0] = 0u; xst[1] = 0u; xst[2] = 0u; xst[3] = 0u; }
    __syncthreads();
    const XcdBarrier xbar = xcd_barrier_post((unsigned*)(p.ws + OFF_BAR), xst);
    for (int rep = 0; rep < REP_PREP; ++rep) phase_prep(p, lds);
    grid.sync();
    if (threadIdx.x == 0) {
        unsigned* bar = (unsigned*)(p.ws + OFF_BAR); bool ok = (gridDim.x % 8u) == 0u;
        for (unsigned j = 0; j < 16; ++j) { const unsigned cnt = xb_ld(&bar[XB_XCNT(j)]); if (j < 8 ? cnt != gridDim.x / 8u : cnt != 0u) ok = false; }
        xst[3] = ok ? xst[2] * 8u + xbar.x : blockIdx.x;
    }
    __syncthreads();
#define VB() __builtin_amdgcn_readfirstlane((int)xst[3])

    for (int step = 0; step < 4; ++step) {
        const int layer = step >> 1;
        if (step & 1) {
            if (layer == 0) {
                { EpiQkv<true> E; E.A = xb; E.ssq = ssq; E.qgain = p.in[10]; E.kgain = p.in[11]; E.cosT = cosT; E.sinT = sinT;
                  E.Q = (bf16_t*)(p.ws + OFF_BIG); E.Kk = (bf16_t*)(p.ws + OFF_BIG + 240 * MiB); E.VT = (bf16_t*)(p.ws + OFF_BIG + 480 * MiB);
                  for (int rep = 0; rep < REP_QKV; ++rep) gemm_phase<4608, 1024>(lds, WB + W_AQKV, E, 0, VB()); }
                xcd_barrier(xbar);
                for (int rep = 0; rep < REP_ATT; ++rep) attn_a_phase<false>(p, lds, 1, 2, VB());
                xcd_barrier(xbar);
                for (int rep = 0; rep < REP_ATT; ++rep) attn_a_phase<true>(p, lds, 0, 1, VB());
                xcd_barrier(xbar);
                { EpiResid E; E.A = (const bf16_t*)(p.ws + OFF_BIG + 80 * MiB); E.K = 512; E.blocked = 0; E.xout = p.x; E.xb = xb; E.ssq = ssq; E.alpha = 1.0f; E.final = 0;
                  gemm_phase<1024, 512>(lds, WB + W_AWO, E, 1, VB()); }
                xcd_barrier(xbar);
            } else {
                { EpiQkv<false> E; E.A = xb; E.ssq = ssq; E.qgain = p.in[14]; E.kgain = p.in[15]; E.cosT = cosT; E.sinT = sinT;
                  E.Q = (bf16_t*)(p.ws + OFF_BIG); E.Kk = (bf16_t*)(p.ws + OFF_BIG + 160 * MiB); E.VT = (bf16_t*)(p.ws + OFF_BIG + 320 * MiB);
                  for (int rep = 0; rep < REP_QKV; ++rep) gemm_phase<3072, 1024>(lds, WB + W_BQKV, E, 0, VB()); }
                xcd_barrier(xbar);
                for (int rep = 0; rep < REP_ATT; ++rep) attn_b_phase(p, lds, VB());
                xcd_barrier(xbar);
                { EpiResid E; E.A = (const bf16_t*)(p.ws + OFF_BIG + 480 * MiB); E.K = 1024; E.blocked = 0; E.xout = p.x; E.xb = xb; E.ssq = ssq; E.alpha = 1.0f; E.final = 0;
                  gemm_phase<1024, 1024>(lds, WB + W_BWO, E, 1, VB()); }
                xcd_barrier(xbar);
            }
        }
        for (int rep = 0; rep < REP_SWI; ++rep) { EpiSwiglu E; E.A = xb; E.H = hbuf; E.ssq = ssq; gemm_phase<5632, 1024>(lds, WB + W_IN0 + (size_t)step * WIN_SZ, E, 0, VB()); }
        xcd_barrier(xbar);
        for (int rep = 0; rep < REP_FOUT; ++rep) { EpiResid E; E.A = hbuf; E.K = DFF; E.blocked = 1; E.xout = p.x; E.xb = xb; E.ssq = ssq; E.alpha = (rep == REP_FOUT - 1) ? 0.5f : 0.0f; E.final = (step == 3 && rep == REP_FOUT - 1) ? 1 : 0; gemm_phase<1024, DFF>(lds, WB + W_OUT0 + (size_t)step * WOUT_SZ, E, 1, VB()); }
        if (step < 3) xcd_barrier(xbar);
    }
}

extern "C" void kernel_launch(void* const* d_in, const int* in_sizes, int n_in, void* d_out, int out_size, void* d_ws, size_t ws_size, hipStream_t stream) {
    static int grid_blocks = 0;
    if (!grid_blocks) {
        hipFuncSetAttribute((const void*)mega_kernel, hipFuncAttributeMaxDynamicSharedMemorySize, LDS_BYTES);
        int dev = 0, cus = 0, per_cu = 0;
        hipGetDevice(&dev);
        hipDeviceGetAttribute(&cus, hipDeviceAttributeMultiprocessorCount, dev);
        hipOccupancyMaxActiveBlocksPerMultiprocessor(&per_cu, mega_kernel, 512, LDS_BYTES);
        if (per_cu < 1) per_cu = 1;
        grid_blocks = cus;
    }
    Params p{};
    for (int i = 0; i < 18; ++i) p.in[i] = (const float*)d_in[i];
    p.x = (float*)d_out;
    p.ws = (unsigned char*)d_ws;
    hipMemsetAsync((unsigned char*)d_ws + OFF_BAR, 0, XCD_BAR_WORDS * sizeof(unsigned), stream);
    void* args[] = {&p};
    hipError_t e = hipLaunchCooperativeKernel((void*)mega_kernel, dim3(grid_blocks), dim3(512), args, LDS_BYTES, stream);
    if (e != hipSuccess) fprintf(stderr, "cooperative launch failed: %s (grid %d)\n", hipGetErrorString(e), grid_blocks);
}
```

```cpp
#include <hip/hip_runtime.h>
#include <hip/hip_cooperative_groups.h>
#include <cstdio>
namespace cg = cooperative_groups;

#define LAS __attribute__((address_space(3)))
#define DI __device__ __forceinline__
typedef unsigned short bf16_t;
typedef short bf16x8 __attribute__((ext_vector_type(8)));
typedef float f32x4 __attribute__((ext_vector_type(4)));
typedef float f32x2 __attribute__((ext_vector_type(2)));
typedef float f32x16 __attribute__((ext_vector_type(16)));
typedef unsigned u32x4 __attribute__((ext_vector_type(4)));
typedef unsigned u32x2 __attribute__((ext_vector_type(2)));

constexpr int MTOK = 81920, DM = 1024, DFF = 2816, S0 = 16384, S1 = 8192;
constexpr int BM = 256, BK = 64, HALF = 128, HTB = HALF * BK * 2, STAGE_BYTES = 8 * HTB, NXCD = 8, WGM = 8;
constexpr int LDS_BYTES = 150016;
constexpr float RMS_EPS = 1e-6f;
#ifndef REP_ATT
#define REP_ATT 1
#endif
#ifndef REP_SWI
#define REP_SWI 1
#endif
#ifndef REP_FOUT
#define REP_FOUT 1
#endif
#ifndef REP_QKV
#define REP_QKV 1
#endif
#ifndef REP_PREP
#define REP_PREP 1
#endif

constexpr size_t MiB = 1024ull * 1024ull;
constexpr size_t OFF_WB = 0;
constexpr size_t OFF_XB = 84 * MiB;
constexpr size_t OFF_SSQ = 244 * MiB;
constexpr size_t OFF_COS = 249 * MiB;
constexpr size_t OFF_SIN = 251 * MiB;
constexpr size_t OFF_LSE = 253 * MiB;
constexpr size_t OFF_BAR = 1000 * MiB;
constexpr int XB_LDS_OFF = 150000;
constexpr int RS_OFF = 131072;
constexpr size_t OFF_BIG = 258 * MiB;
constexpr size_t WIN_SZ = (size_t)1024 * 5632, WOUT_SZ = (size_t)2816 * 1024;
constexpr size_t W_IN0 = 0, W_OUT0 = 4 * WIN_SZ, W_AQKV = W_OUT0 + 4 * WOUT_SZ, W_AWO = W_AQKV + (size_t)1024 * 4608,
                 W_BQKV = W_AWO + (size_t)512 * 1024, W_BWO = W_BQKV + (size_t)1024 * 3072;

struct Params {
    const float* in[18];
    float* x;
    unsigned char* ws;
};

__constant__ double c_inv_freq[32] = {
    1.0, 0.7498942093324559, 0.5623413251903491, 0.4216965034285822,
    0.31622776601683794, 0.23713737056616552, 0.1778279410038923, 0.1333521432163324,
    0.1, 0.07498942093324558, 0.05623413251903491, 0.042169650342858224,
    0.03162277660168379, 0.023713737056616554, 0.01778279410038923, 0.01333521432163324,
    0.01, 0.007498942093324558, 0.005623413251903491, 0.004216965034285823,
    0.0031622776601683794, 0.0023713737056616554, 0.0017782794100389228, 0.001333521432163324,
    0.001, 0.0007498942093324559, 0.0005623413251903491, 0.00042169650342858224,
    0.00031622776601683794, 0.00023713737056616554, 0.00017782794100389227, 0.0001333521432163324};

DI unsigned pk_bf16(float lo, float hi) { unsigned r; asm("v_cvt_pk_bf16_f32 %0, %1, %2" : "=v"(r) : "v"(lo), "v"(hi)); return r; }
DI unsigned pk_bf16_nop(float lo, float hi) { unsigned r; asm volatile("v_cvt_pk_bf16_f32 %0, %1, %2\n\ts_nop 1" : "=v"(r) : "v"(lo), "v"(hi)); return r; }
DI float bf_lo(unsigned w) { return __uint_as_float(w << 16); }
DI float bf_hi(unsigned w) { return __uint_as_float(w & 0xffff0000u); }

DI int lds_byte(int r, int c) { const int st = (r >> 4) * 2 + (c >> 5), rr = r & 15, cc = c & 31, ob = rr * 64 + cc * 2; return st * 1024 + (ob ^ (((ob >> 9) & 1) << 5)); }
DI void stage_rc(int b, int& R, int& C) { const int st = b / 1024, sb = b % 1024, swz = sb ^ (((sb >> 9) & 1) << 5); R = (st >> 1) * 16 + swz / 64; C = (st & 1) * 32 + (swz % 64) / 2; }
DI int perm32(int rho) { const int n = rho >> 4, i = rho & 15; return 8 * (i >> 2) + 4 * n + (i & 3); }

struct Unit { int pm, pn; };
struct AMap { const char* base; unsigned pitch; };

template <int NT> struct StaticOrderT {
    static constexpr int nM = MTOK / BM, nN = NT, nwg = nM * nN;
    int G, c, rev;
    DI void init(int G_, int c_, int rev_) { G = G_; c = c_; rev = rev_; }
    DI bool next(int i, Unit& u) const {
        const long L = (long)i * G + c; if (L >= nwg) return false;
        int wgid = (int)L; { const int q = nwg / NXCD, r = nwg % NXCD, xcd = wgid % NXCD, off = wgid / NXCD; wgid = (xcd < r ? xcd * (q + 1) : r * (q + 1) + (xcd - r) * q) + off; }
        constexpr int nig = WGM * nN; static_assert(nM % WGM == 0, "row tiles divide into full groups");
        const int gid = wgid / nig, fm = gid * WGM, rem = wgid - gid * nig;
        u.pm = fm + (rem % WGM); u.pn = rem / WGM; if (rev) u.pm = nM - 1 - u.pm; return true;
    }
};

DI void seq_of(int row, int& base, int& S) { if (row < S0) { base = 0; S = S0; } else { base = S0 + ((row - S0) & ~(S1 - 1)); S = S1; } }

DI void rstd8(const LAS unsigned char* rsl, int rl0, int fq, float (&rs)[8]) {
    f32x4 pp[8];
#pragma unroll
    for (int i = 0; i < 8; ++i) pp[i] = *(const LAS f32x4*)(rsl + (rl0 + (i >> 2) * HALF + (i & 3) * 16) * 64 + 16 * fq);
#pragma unroll
    for (int i = 0; i < 8; ++i) { float ss = (pp[i].x + pp[i].y) + (pp[i].z + pp[i].w); ss += __shfl_xor(ss, 16); ss += __shfl_xor(ss, 32); rs[i] = rsqrtf(ss * (1.0f / 1024.0f) + RMS_EPS); }
}

#ifndef REP_EPI_SWI
#define REP_EPI_SWI 1
#endif
struct EpiSwiglu {
    const bf16_t* A; bf16_t* H; const float* ssq;
    DI int nrep() const { return REP_EPI_SWI; }
    static constexpr bool NEEDS_RSTD = true; DI const char* ssq_base(const Unit& u, unsigned& pitch) const { pitch = 64u; return (const char*)(ssq + (size_t)(u.pm * BM) * 16); }
    DI AMap amap(const Unit& u) const { AMap a; a.base = (const char*)A + (size_t)u.pm * BM * DM * 2; a.pitch = DM * 2u; return a; }
    DI size_t kstepA() const { return 128; }
    DI void operator()(const f32x4 (&acc)[2][2][4][2], const Unit& u, int wr, int wc, int fr, int fq, const LAS unsigned char* rsl) const {
        const int row0 = u.pm * BM + wr * 64 + fr;
        float rs[8]; rstd8(rsl, wr * 64 + fr, fq, rs);
        bf16_t* hp = H + ((size_t)(u.pm * (DFF / 64) + 2 * u.pn + (wc >> 1)) * 256 + (wr * 64 + fr)) * 64 + (wc & 1) * 32 + 8 * fq;
#pragma unroll
        for (int ai = 0; ai < 2; ++ai)
#pragma unroll
            for (int m = 0; m < 4; ++m) {
                const float rstd = rs[4 * ai + m], c1 = -1.4426950408889634f * rstd, r2 = rstd * rstd;
                const f32x2 c1v = (f32x2){c1, c1}, r2v = (f32x2){r2, r2}, onev = (f32x2){1.0f, 1.0f};
                f32x2 av[4], bv[4], tv[4], hv2[4];
#pragma unroll
                for (int n = 0; n < 2; ++n) { const f32x4 A4 = acc[ai][0][m][n], B4 = acc[ai][1][m][n];
                    av[2 * n] = __builtin_shufflevector(A4, A4, 0, 1); av[2 * n + 1] = __builtin_shufflevector(A4, A4, 2, 3);
                    bv[2 * n] = __builtin_shufflevector(B4, B4, 0, 1); bv[2 * n + 1] = __builtin_shufflevector(B4, B4, 2, 3); }
#pragma unroll
                for (int i = 0; i < 4; ++i) tv[i] = av[i] * c1v;
#pragma unroll
                for (int i = 0; i < 4; ++i) { tv[i].x = __builtin_amdgcn_exp2f(tv[i].x); tv[i].y = __builtin_amdgcn_exp2f(tv[i].y); }
#pragma unroll
                for (int i = 0; i < 4; ++i) { tv[i] = tv[i] + onev; hv2[i] = (av[i] * bv[i]) * r2v; }
#pragma unroll
                for (int i = 0; i < 4; ++i) { tv[i].x = __builtin_amdgcn_rcpf(tv[i].x); tv[i].y = __builtin_amdgcn_rcpf(tv[i].y); }
                float hv[8];
#pragma unroll
                for (int i = 0; i < 4; ++i) { const f32x2 h = hv2[i] * tv[i]; hv[2 * i] = h.x; hv[2 * i + 1] = h.y; }
                u32x4 w; w.x = pk_bf16(hv[0], hv[1]); w.y = pk_bf16(hv[2], hv[3]); w.z = pk_bf16(hv[4], hv[5]); w.w = pk_bf16(hv[6], hv[7]);
                *(u32x4*)(hp + (size_t)(ai * HALF + m * 16) * 64) = w;
            }
    }
};

struct EpiResid {
    const bf16_t* A; int K; float* xout; bf16_t* xb; float* ssq; float alpha; int final;
    DI int nrep() const { return 1; }
    static constexpr bool NEEDS_RSTD = false; DI const char* ssq_base(const Unit&, unsigned& pitch) const { pitch = 0u; return nullptr; }
    int blocked;
    DI AMap amap(const Unit& u) const { AMap a; a.base = (const char*)A + (size_t)u.pm * BM * K * 2; a.pitch = blocked ? 128u : (unsigned)K * 2u; return a; }
    DI size_t kstepA() const { return blocked ? 32768 : 128; }
    DI void operator()(const f32x4 (&acc)[2][2][4][2], const Unit& u, int wr, int wc, int fr, int fq, const LAS unsigned char* rsl) const {
        const int col0 = u.pn * BM + wc * 32 + 8 * fq, row0 = u.pm * BM + wr * 64 + fr;
        bf16_t* b0 = xb + (size_t)row0 * DM + col0;
        u32x4 cur[2], nx[2];
        cur[0] = *(const u32x4*)(b0); cur[1] = *(const u32x4*)(b0 + HALF);
#pragma unroll
        for (int idx = 0; idx < 8; ++idx) {
            const int ai = idx >> 2, m = idx & 3;
            if (idx < 7) { const bf16_t* nb = b0 + (size_t)(((idx + 1) >> 2) * HALF + ((idx + 1) & 3) * 16) * DM; nx[0] = *(const u32x4*)(nb); nx[1] = *(const u32x4*)(nb + HALF); }
            asm volatile("" ::: "memory");
            const int row = row0 + ai * HALF + m * 16;
            bf16_t* br = b0 + (size_t)(ai * HALF + m * 16) * DM;
            float part = 0.f;
#pragma unroll
            for (int bj = 0; bj < 2; ++bj) {
                const u32x4 xo = cur[bj];
                f32x4 o0 = (f32x4){bf_lo(xo.x), bf_hi(xo.x), bf_lo(xo.y), bf_hi(xo.y)}, o1 = (f32x4){bf_lo(xo.z), bf_hi(xo.z), bf_lo(xo.w), bf_hi(xo.w)};
                o0 += alpha * acc[ai][bj][m][0]; o1 += alpha * acc[ai][bj][m][1];
                if (final) { float* xr = xout + (size_t)row * DM + col0 + bj * HALF; *(f32x4*)(xr) = o0; *(f32x4*)(xr + 4) = o1; }
                else {
                    part += (o0.x * o0.x + o0.y * o0.y) + (o0.z * o0.z + o0.w * o0.w) + (o1.x * o1.x + o1.y * o1.y) + (o1.z * o1.z + o1.w * o1.w);
                    u32x4 w; w.x = pk_bf16(o0.x, o0.y); w.y = pk_bf16(o0.z, o0.w); w.z = pk_bf16(o1.x, o1.y); w.w = pk_bf16(o1.z, o1.w);
                    *(u32x4*)(br + bj * HALF) = w;
                }
            }
            if (!final) { part += __shfl_xor(part, 16); part += __shfl_xor(part, 32);
                if (fq == 0) ssq[(size_t)row * 16 + u.pn * 4 + wc] = part; }
            if (idx < 7) { cur[0] = nx[0]; cur[1] = nx[1]; }
            asm volatile("" ::: "memory");
        }
    }
};

template <bool MIXA> struct EpiQkv {
    const bf16_t* A; const float* ssq; const float* qgain; const float* kgain; const float* cosT; const float* sinT;
    bf16_t* Q; bf16_t* Kk; bf16_t* VT;
    DI int nrep() const { return 1; }
    static constexpr bool NEEDS_RSTD = true; DI const char* ssq_base(const Unit& u, unsigned& pitch) const { int t0, d, p0; geom(u, t0, d, p0); pitch = 64u * (unsigned)d; return (const char*)(ssq + (size_t)t0 * 16); }
    DI void geom(const Unit& u, int& tokrow0, int& d, int& pos0) const {
        if (MIXA) {
            const int g = (u.pn % 6) >> 1, sh = 2 * g; int base, S; seq_of(u.pm * BM, base, S);
            const int lgL = (S == S0 ? 14 : 13) - sh, off = u.pm * BM - base, r = off >> lgL, m0 = off - (r << lgL);
            d = 1 << sh; pos0 = m0 * d + r; tokrow0 = base + pos0;
        } else { d = 1; tokrow0 = u.pm * BM; pos0 = 0; }
    }
    DI AMap amap(const Unit& u) const { int t0, d, p0; geom(u, t0, d, p0); AMap a; a.base = (const char*)A + (size_t)t0 * DM * 2; a.pitch = (unsigned)d * (DM * 2u); return a; }
    DI size_t kstepA() const { return 128; }
    DI void operator()(const f32x4 (&acc)[2][2][4][2], const Unit& u, int wr, int wc, int fr, int fq, const LAS unsigned char* rsl) const {
        int tok0, d, pos0; geom(u, tok0, d, pos0);
        const int t = MIXA ? u.pn / 6 : u.pn / 4;
        const int g = MIXA ? (u.pn % 6) >> 1 : 0;
        const int head = MIXA ? 4 * (u.pn & 1) + wc : 4 * (u.pn & 3) + wc;
        constexpr int HD = MIXA ? 512 : 1024;
        const int i0 = wr * 64 + fr;
        float rs[8]; rstd8(rsl, i0, fq, rs);
        if (t < 2) {
            const float* gn = t == 0 ? qgain : kgain;
            f32x4 gv[2][2];
#pragma unroll
            for (int bj = 0; bj < 2; ++bj)
#pragma unroll
                for (int n = 0; n < 2; ++n) gv[bj][n] = *(const f32x4*)(gn + 32 * bj + 8 * fq + 4 * n);
            bf16_t* dst = (t == 0 ? Q : Kk) + (size_t)g * MTOK * HD + (size_t)(u.pm * BM + i0) * HD + head * 64 + 8 * fq;
            const float sc = t == 0 ? 0.125f * 1.4426950408889634f : 1.0f;
            const float* cp = cosT + (size_t)(pos0 + i0 * d) * 32 + 8 * fq; const float* sp = sinT + (size_t)(pos0 + i0 * d) * 32 + 8 * fq;
            f32x4 cc[2], sn[2], ncc[2], nsn[2];
            if (MIXA) { cc[0] = *(const f32x4*)(cp); cc[1] = *(const f32x4*)(cp + 4); sn[0] = *(const f32x4*)(sp); sn[1] = *(const f32x4*)(sp + 4); }
#pragma unroll
            for (int idx = 0; idx < 8; ++idx) {
                const int ai = idx >> 2, m = idx & 3, il = ai * HALF + m * 16;
                if (MIXA && idx < 7) { const size_t o = (size_t)((((idx + 1) >> 2) * HALF + ((idx + 1) & 3) * 16) * d) * 32;
                    ncc[0] = *(const f32x4*)(cp + o); ncc[1] = *(const f32x4*)(cp + o + 4); nsn[0] = *(const f32x4*)(sp + o); nsn[1] = *(const f32x4*)(sp + o + 4); }
                asm volatile("" ::: "memory");
                const float rstd = rs[idx];
                f32x4 v[2][2]; float ss = 0.f;
#pragma unroll
                for (int bj = 0; bj < 2; ++bj)
#pragma unroll
                    for (int n = 0; n < 2; ++n) { v[bj][n] = acc[ai][bj][m][n] * rstd; const f32x4 q2 = v[bj][n] * v[bj][n]; ss += (q2.x + q2.y) + (q2.z + q2.w); }
                ss += __shfl_xor(ss, 16); ss += __shfl_xor(ss, 32);
                const float rn = rsqrtf(ss * (1.0f / 64.0f) + RMS_EPS) * sc;
#pragma unroll
                for (int bj = 0; bj < 2; ++bj)
#pragma unroll
                    for (int n = 0; n < 2; ++n) v[bj][n] = v[bj][n] * rn * gv[bj][n];
                if (MIXA) {
#pragma unroll
                    for (int n = 0; n < 2; ++n) { const f32x4 a = v[0][n], b = v[1][n]; v[0][n] = a * cc[n] - b * sn[n]; v[1][n] = b * cc[n] + a * sn[n]; }
                }
                bf16_t* rp = dst + (size_t)il * HD;
#pragma unroll
                for (int bj = 0; bj < 2; ++bj) {
                    u32x4 w; w.x = pk_bf16(v[bj][0].x, v[bj][0].y); w.y = pk_bf16(v[bj][0].z, v[bj][0].w); w.z = pk_bf16(v[bj][1].x, v[bj][1].y); w.w = pk_bf16(v[bj][1].z, v[bj][1].w);
                    *(u32x4*)(rp + 32 * bj) = w;
                }
                if (MIXA && idx < 7) { cc[0] = ncc[0]; cc[1] = ncc[1]; sn[0] = nsn[0]; sn[1] = nsn[1]; }
                asm volatile("" ::: "memory");
            }
        } else {
            bf16_t* dst = VT + (size_t)g * MTOK * HD + (size_t)(u.pm * BM + i0) * HD + head * 64 + 8 * fq;
#pragma unroll
            for (int ai = 0; ai < 2; ++ai)
#pragma unroll
                for (int m = 0; m < 4; ++m) {
                    const float rstd = rs[4 * ai + m];
                    bf16_t* rp = dst + (size_t)(ai * HALF + m * 16) * HD;
#pragma unroll
                    for (int bj = 0; bj < 2; ++bj) {
                        const f32x4 v0 = acc[ai][bj][m][0] * rstd, v1 = acc[ai][bj][m][1] * rstd;
                        u32x4 w; w.x = pk_bf16(v0.x, v0.y); w.y = pk_bf16(v0.z, v0.w); w.z = pk_bf16(v1.x, v1.y); w.w = pk_bf16(v1.z, v1.w);
                        *(u32x4*)(rp + 32 * bj) = w;
                    }
                }
        }
    }
};

template <int N, int K, class Epi>
__device__ __forceinline__ void gemm_phase(LAS unsigned char* lds, const bf16_t* Btp, const Epi& E, int rev, int vb) {
    int tid = threadIdx.x; asm volatile("" : "+v"(tid));
    const int wid = __builtin_amdgcn_readfirstlane(tid >> 6), lane = tid & 63, wr = wid >> 2, wc = wid & 3, fr = lane & 15, fq = lane >> 4;
    const int nt = K / BK;
    unsigned voAr, voAc, voffB;
    { int R, C; stage_rc(tid * 16, R, C); const int Rb = (R & ~31) + perm32(R & 31);
      voAr = (unsigned)R; voAc = (unsigned)C * 2u; voffB = (unsigned)(Rb * K + C) * 2u; }
    const size_t kstepA = E.kstepA();
    const size_t kstep = (size_t)(BK * 2);
    const size_t hstepB = (size_t)HALF * K * 2;
    const size_t tstepB = 2 * hstepB;
    const size_t qstepB = hstepB >> 1;
    const unsigned ldsw = (unsigned)wid * 1024u;
    const int aoff = lds_byte(wr * 64 + fr, fq * 8), boff = lds_byte(wc * 32 + fr, fq * 8);
#define G_SA(b, h) (((b) * 2 + (h)) * HTB)
#define G_SB(b, h) ((4 + (b) * 2 + (h)) * HTB)
#define G_STAGE(bufoff, gbase, voff, q64) do { _Pragma("unroll") for (int _i = 0; _i < 2; ++_i) \
        __builtin_amdgcn_global_load_lds((const unsigned*)((const char*)(gbase) + (size_t)_i * (q64) + (voff)), (LAS unsigned*)(lds + (bufoff) + ldsw + _i * 8192), 16, 0, 0); } while (0)
#define G_STB(bufoff, gbase) G_STAGE(bufoff, gbase, voffB, qstepB)
#define G_STA(bufoff, gbase, pitch) G_STAGE(bufoff, gbase, voAr * (pitch) + voAc, (size_t)64 * (pitch))
#define G_LDA(dst, b, h) do { _Pragma("unroll") for (int m = 0; m < 4; ++m) _Pragma("unroll") for (int k = 0; k < 2; ++k) dst[m][k] = *(const LAS bf16x8*)(lds + G_SA(b, h) + aoff + m * 2048 + k * 1024); } while (0)
#define G_LDB(dst, b, h) do { _Pragma("unroll") for (int n = 0; n < 2; ++n) _Pragma("unroll") for (int k = 0; k < 2; ++k) dst[n][k] = *(const LAS bf16x8*)(lds + G_SB(b, h) + boff + n * 2048 + k * 1024); } while (0)
#define G_MMA(ai, bj, At, Bt) do { __builtin_amdgcn_s_setprio(1); _Pragma("unroll") for (int m = 0; m < 4; ++m) _Pragma("unroll") for (int n = 0; n < 2; ++n) _Pragma("unroll") for (int k = 0; k < 2; ++k) \
        acc[ai][bj][m][n] = __builtin_amdgcn_mfma_f32_16x16x32_bf16(Bt[n][k], At[m][k], acc[ai][bj][m][n], 0, 0, 0); __builtin_amdgcn_s_setprio(0); } while (0)
#define G_WAIT_V(n) asm volatile("s_waitcnt vmcnt(" #n ")" ::: "memory")
#define G_WAIT_L(n) asm volatile("s_waitcnt lgkmcnt(" #n ")" ::: "memory")
#define G_BAR __builtin_amdgcn_s_barrier()
#define G_SCHED __builtin_amdgcn_sched_barrier(0)
    StaticOrderT<N / BM> S; S.init((int)gridDim.x, vb, rev);
    Unit cur, nxt; int ui = 0;
    if (!S.next(0, cur)) return;
    f32x4 acc[2][2][4][2];
#pragma unroll
    for (int a = 0; a < 2; ++a)
#pragma unroll
        for (int b = 0; b < 2; ++b)
#pragma unroll
            for (int m = 0; m < 4; ++m)
#pragma unroll
                for (int n = 0; n < 2; ++n) acc[a][b][m][n] = (f32x4){0.f, 0.f, 0.f, 0.f};
    bf16x8 At[4][2], B0[2][2], B1[2][2];
    AMap am = E.amap(cur);
    const char* cA = am.base; const char* cB = (const char*)Btp + (size_t)cur.pn * tstepB;
    unsigned mulA = am.pitch;
    G_STB(G_SB(0, 0), cB); G_STA(G_SA(0, 0), cA, mulA); G_STB(G_SB(0, 1), cB + hstepB); G_STA(G_SA(0, 1), cA + (size_t)HALF * mulA, mulA);
    if (wr == 1) G_BAR;
    G_WAIT_V(4); G_BAR;
    G_STB(G_SB(1, 0), cB + kstep); G_STA(G_SA(1, 0), cA + kstepA, mulA); G_STB(G_SB(1, 1), cB + hstepB + kstep);
    G_WAIT_V(6); G_BAR;
    for (;;) {
        const bool has_next = S.next(ui + 1, nxt);
        AMap an; if (has_next) an = E.amap(nxt); else { an.base = cA; an.pitch = mulA; }
        const char* nA = an.base; const char* nB = has_next ? (const char*)Btp + (size_t)nxt.pn * tstepB : cB;
        const unsigned mulN = an.pitch;
        if (Epi::NEEDS_RSTD) {
            unsigned sp; const char* sb = E.ssq_base(cur, sp);
#pragma unroll
            for (int j = 0; j < 2; ++j) { const int k = 2 * wc + j, rb = (k >> 2) * HALF + wr * 64 + (k & 3) * 16; const unsigned vo = (unsigned)(lane >> 2) * sp + (unsigned)(lane & 3) * 16u;
                __builtin_amdgcn_global_load_lds((const unsigned*)(sb + (size_t)rb * sp + vo), (LAS unsigned*)(lds + RS_OFF + (rb >> 4) * 1024), 16, 0, 0); }
        }
        _Pragma("nounroll") for (int t = 0; t < nt; t += 2) {
            const bool last = (t == nt - 2);
            const char* a1 = cA + (size_t)(t + 1) * kstepA;
            const char* a2 = last ? nA : cA + (size_t)(t + 2) * kstepA; const char* b2 = last ? nB : cB + (size_t)(t + 2) * kstep;
            const char* a3 = a2 + kstepA; const char* b3 = b2 + kstep;
            const unsigned mul2 = last ? mulN : mulA;
            G_LDB(B0, 0, 0); G_SCHED; G_LDA(At, 0, 0); G_STA(G_SA(1, 1), a1 + (size_t)HALF * mulA, mulA);
            G_WAIT_L(8); G_BAR; G_WAIT_L(0); G_MMA(0, 0, At, B0); G_BAR; G_SCHED;
            G_LDB(B1, 0, 1); G_STB(G_SB(0, 0), b2);
            G_BAR; G_WAIT_L(0); G_MMA(0, 1, At, B1); G_BAR;
            G_LDA(At, 0, 1); G_STA(G_SA(0, 0), a2, mul2);
            G_BAR; G_WAIT_L(0); G_MMA(1, 0, At, B0); G_BAR; G_SCHED;
            G_STB(G_SB(0, 1), b2 + hstepB);
            G_WAIT_V(6); G_BAR; G_MMA(1, 1, At, B1); G_BAR;
            G_LDB(B0, 1, 0); G_SCHED; G_LDA(At, 1, 0); G_STA(G_SA(0, 1), a2 + (size_t)HALF * mul2, mul2);
            G_WAIT_L(8); G_BAR; G_WAIT_L(0); G_MMA(0, 0, At, B0); G_BAR; G_SCHED;
            G_LDB(B1, 1, 1); G_STB(G_SB(1, 0), b3);
            G_BAR; G_WAIT_L(0); G_MMA(0, 1, At, B1); G_BAR;
            G_LDA(At, 1, 1); G_STA(G_SA(1, 0), a3, mul2);
            G_BAR; G_WAIT_L(0); G_MMA(1, 0, At, B0); G_BAR; G_SCHED;
            G_STB(G_SB(1, 1), b3 + hstepB);
            G_WAIT_V(6); G_BAR; G_MMA(1, 1, At, B1); G_BAR;
        }
        for (int rep_e = 0; rep_e < E.nrep(); ++rep_e) { E(acc, cur, wr, wc, fr, fq, lds + RS_OFF); asm volatile("" ::: "memory"); }
        if (!has_next) break;
        if (Epi::NEEDS_RSTD) { asm volatile("s_waitcnt lgkmcnt(0)" ::: "memory"); G_BAR; }
#pragma unroll
        for (int a = 0; a < 2; ++a)
#pragma unroll
            for (int b = 0; b < 2; ++b)
#pragma unroll
                for (int m = 0; m < 4; ++m)
#pragma unroll
                    for (int n = 0; n < 2; ++n) acc[a][b][m][n] = (f32x4){0.f, 0.f, 0.f, 0.f};
        cur = nxt; cA = nA; cB = nB; mulA = mulN; ++ui;
    }
    G_WAIT_V(0);
    if (wr == 0) G_BAR;
    G_BAR;
#undef G_SA
#undef G_SB
#undef G_STAGE
#undef G_STA
#undef G_STB
#undef G_LDA
#undef G_LDB
#undef G_MMA
}

DI int lmap(int kind, int p) {
    if (kind == 1) { const int pn = p >> 8, bj = (p >> 7) & 1, q = p & 127; return bj * DFF + pn * 128 + q; }
    if (kind == 2) { const int pn = p >> 8, bj = (p >> 7) & 1, wc = (p >> 5) & 3, j = p & 31; return pn * 256 + wc * 64 + bj * 32 + j; }
    return p;
}
DI void prep_weight_tile(const float* W, const float* gain, bf16_t* Bt, int K, int N, int kind, int tl, LAS float* T, int tid) {
    const int ntp = N >> 8, kt = tl / ntp, pt = tl - kt * ntp, k0 = kt * 64, p0 = pt * 256;
    { const int ty = tid >> 6, tx = tid & 63; float wv[4][8];
#pragma unroll
      for (int s = 0; s < 4; ++s) { const int Lc = lmap(kind, p0 + 64 * s + tx);
#pragma unroll
          for (int i = 0; i < 8; ++i) wv[s][i] = W[(size_t)(k0 + ty + 8 * i) * N + Lc]; }
      float gk[8];
#pragma unroll
      for (int i = 0; i < 8; ++i) gk[i] = gain ? gain[k0 + ty + 8 * i] : 1.0f;
#pragma unroll
      for (int s = 0; s < 4; ++s)
#pragma unroll
          for (int i = 0; i < 8; ++i) T[s * 4160 + (ty + 8 * i) * 65 + tx] = wv[s][i] * gk[i]; }
    __syncthreads();
    { const int py = tid >> 3, kx = tid & 7;
#pragma unroll
      for (int s = 0; s < 4; ++s) { const LAS float* Ts = T + s * 4160; u32x4 o;
          o.x = pk_bf16(Ts[(kx * 8 + 0) * 65 + py], Ts[(kx * 8 + 1) * 65 + py]); o.y = pk_bf16(Ts[(kx * 8 + 2) * 65 + py], Ts[(kx * 8 + 3) * 65 + py]);
          o.z = pk_bf16(Ts[(kx * 8 + 4) * 65 + py], Ts[(kx * 8 + 5) * 65 + py]); o.w = pk_bf16(Ts[(kx * 8 + 6) * 65 + py], Ts[(kx * 8 + 7) * 65 + py]);
          *(u32x4*)(Bt + (size_t)(p0 + 64 * s + py) * K + k0 + kx * 8) = o; } }
    __syncthreads();
}

__device__ __forceinline__ void phase_prep(const Params& p, LAS unsigned char* lds) {
    bf16_t* WB = (bf16_t*)(p.ws + OFF_WB);
    LAS float* T = (LAS float*)lds;
    int tid = threadIdx.x; asm volatile("" : "+v"(tid));
    for (int tile = blockIdx.x; tile < 2688; tile += gridDim.x) {
        const float* W; const float* gain = nullptr; bf16_t* Bt; int K, N, kind, tl;
        if (tile < 1408) { const int s = tile / 352; tl = tile - s * 352; K = 1024; N = 5632; kind = 1;
            W = ((s & 1) ? p.in[7] : p.in[3]) + (size_t)(s >> 1) * WIN_SZ; gain = ((s & 1) ? p.in[6] : p.in[2]) + (s >> 1) * 1024; Bt = WB + W_IN0 + (size_t)s * WIN_SZ; }
        else if (tile < 2112) { const int s = (tile - 1408) / 176; tl = (tile - 1408) - s * 176; K = 2816; N = 1024; kind = 0;
            W = ((s & 1) ? p.in[8] : p.in[4]) + (size_t)(s >> 1) * WOUT_SZ; Bt = WB + W_OUT0 + (size_t)s * WOUT_SZ; }
        else if (tile < 2400) { tl = tile - 2112; K = 1024; N = 4608; kind = 2; W = p.in[9]; gain = p.in[5]; Bt = WB + W_AQKV; }
        else if (tile < 2432) { tl = tile - 2400; K = 512; N = 1024; kind = 0; W = p.in[12]; Bt = WB + W_AWO; }
        else if (tile < 2624) { tl = tile - 2432; K = 1024; N = 3072; kind = 2; W = p.in[13]; gain = p.in[5] + 1024; Bt = WB + W_BQKV; }
        else { tl = tile - 2624; K = 1024; N = 1024; kind = 0; W = p.in[17]; Bt = WB + W_BWO; }
        prep_weight_tile(W, gain, Bt, K, N, kind, tl, T, tid);
    }
    { float* cosT = (float*)(p.ws + OFF_COS); float* sinT = (float*)(p.ws + OFF_SIN);
      for (int idx = blockIdx.x * 512 + tid; idx < S0 * 32; idx += gridDim.x * 512) {
          const int pos = idx >> 5, i = idx & 31;
          const double ang = (double)pos * c_inv_freq[i];
          double t = ang * 0.15915494309189535; t -= __builtin_rint(t);
          const float tf = (float)(2.0 * t);
          cosT[idx] = cospif(tf); sinT[idx] = sinpif(tf);
      } }
    { bf16_t* xb = (bf16_t*)(p.ws + OFF_XB); float* ssq = (float*)(p.ws + OFF_SSQ);
      const int lane = tid & 63, wid = tid >> 6;
      const int rstride = gridDim.x * 8;
      for (int row = blockIdx.x * 8 + wid; row < MTOK; row += 4 * rstride) {
          f32x4 v[4][4];
#pragma unroll
          for (int rr = 0; rr < 4; ++rr) { const int r2 = row + rr * rstride; if (r2 < MTOK) {
              const float* src = r2 < S0 ? p.in[0] + (size_t)r2 * DM : p.in[1] + (size_t)(r2 - S0) * DM;
#pragma unroll
              for (int j = 0; j < 4; ++j) v[rr][j] = *(const f32x4*)(src + 4 * lane + 256 * j); } }
#pragma unroll
          for (int rr = 0; rr < 4; ++rr) { const int r2 = row + rr * rstride; if (r2 < MTOK) {
              float ss = 0.f;
#pragma unroll
              for (int j = 0; j < 4; ++j) { const f32x4 q = v[rr][j] * v[rr][j]; ss += (q.x + q.y) + (q.z + q.w); }
#pragma unroll
              for (int o = 32; o >= 1; o >>= 1) ss += __shfl_xor(ss, o);
#pragma unroll
              for (int j = 0; j < 4; ++j) {
                  u32x2 w; w.x = pk_bf16(v[rr][j].x, v[rr][j].y); w.y = pk_bf16(v[rr][j].z, v[rr][j].w); *(u32x2*)(xb + (size_t)r2 * DM + 4 * lane + 256 * j) = w; }
              if (lane < 16) ssq[(size_t)r2 * 16 + lane] = lane == 0 ? ss : 0.f; } }
      } }
}

#define MFMA32(a, b, c) __builtin_amdgcn_mfma_f32_32x32x16_bf16((a), (b), (c), 0, 0, 0)
#define MFMA16(a, b, c) __builtin_amdgcn_mfma_f32_16x16x32_bf16((a), (b), (c), 0, 0, 0)
DI int crow(int reg, int h) { return (reg & 3) + 8 * (reg >> 2) + 4 * h; }

DI int kswz(int row, int ch) { return row * 128 + ((ch ^ ((row >> 1) & 7)) << 4); }
constexpr int AK_BYTES = 384 * 128;
constexpr int BK_BYTES = 576 * 128, BV_BYTES = 576 * 128;
DI int vswz_a(int row, int ch) { return row * 128 + ((ch ^ (((row >> 1) & 1) << 2)) << 4); }
DI int vswz_b(int row, int ch) { return row * 128 + (((((ch >> 1) ^ ((row >> 1) & 3)) << 1) | (ch & 1)) << 4); }
typedef short s16x4 __attribute__((ext_vector_type(4)));
DI u32x2 tr_read(const LAS unsigned char* p) { const s16x4 v = __builtin_amdgcn_ds_read_tr16_b64_v4i16((LAS s16x4*)p); return __builtin_bit_cast(u32x2, v); }
constexpr int B_RPB_OFF = BK_BYTES + BV_BYTES;

DI void attn_a_qload(const Params& p, int g, int head, int qb, int w, int lane, bf16x8 (&qf)[4]) {
    const bf16_t* Qg = (const bf16_t*)(p.ws + OFF_BIG) + (size_t)g * MTOK * 512;
    const int R0 = qb * 256 + 32 * w, q = lane & 31, hh = lane >> 5;
#pragma unroll
    for (int kk = 0; kk < 4; ++kk) qf[kk] = *(const bf16x8*)(Qg + (size_t)(R0 + q) * 512 + head * 64 + 16 * kk + 8 * hh);
}
DI void attn_a_prefetch(const Params& p, int g, int head, int qb, int tid, u32x4 (&kr)[6], u32x4 (&vr)[6]) {
    const bf16_t* Kg = (const bf16_t*)(p.ws + OFF_BIG + 240 * MiB) + (size_t)g * MTOK * 512 + head * 64;
    const bf16_t* Vg = (const bf16_t*)(p.ws + OFF_BIG + 480 * MiB) + (size_t)g * MTOK * 512 + head * 64;
    const int R0 = qb * 256;
#pragma unroll
    for (int i = 0; i < 6; ++i) { const int c = tid + 512 * i, row = c >> 3, ch = c & 7; int k = R0 - 64 + row; k = k < 0 ? 0 : (k > MTOK - 1 ? MTOK - 1 : k);
        kr[i] = *(const u32x4*)(Kg + (size_t)k * 512 + ch * 8); vr[i] = *(const u32x4*)(Vg + (size_t)k * 512 + ch * 8); }
}
DI void attn_a_stage(LAS unsigned char* lds, int tid, const u32x4 (&kr)[6], const u32x4 (&vr)[6]) {
#pragma unroll
    for (int i = 0; i < 6; ++i) { const int c = tid + 512 * i, row = c >> 3, ch = c & 7; *(LAS u32x4*)(lds + kswz(row, ch)) = kr[i]; *(LAS u32x4*)(lds + AK_BYTES + vswz_a(row, ch)) = vr[i]; }
}

template <bool MERGE>
__device__ __forceinline__ void attn_a_compute(const Params& p, const LAS unsigned char* lds, int g, int head, int qb, int w, int lane, const bf16x8 (&qf)[4]) {
    const int R0 = qb * 256 + 32 * w, q = lane & 31, hh = lane >> 5, sh = 2 * g, kl0 = 32 * w;
    int base, S; seq_of(R0, base, S);
    const int L = S >> sh, lo = base + ((R0 - base) & ~(L - 1)), hi = lo + L;
    f32x16 s[5];
#pragma unroll
    for (int kt = 0; kt < 5; ++kt) {
        bf16x8 kf[4];
#pragma unroll
        for (int kk = 0; kk < 4; ++kk) kf[kk] = *(const LAS bf16x8*)(lds + kswz(kl0 + 32 * kt + q, 2 * kk + hh));
#pragma unroll
        for (int i = 0; i < 16; ++i) s[kt][i] = 0.f;
#pragma unroll
        for (int kk = 0; kk < 4; ++kk) s[kt] = MFMA32(kf[kk], qf[kk], s[kt]);
    }
    const int qrow = R0 + q;
    float mx = -3.0e38f;
    if (R0 - 64 >= lo && R0 + 96 <= hi) {
        const int u = 4 * hh - q;
#pragma unroll
        for (int r = 0; r < 16; ++r) { const float v = (u >= -crow(r, 0)) ? s[0][r] : -1.0e30f; s[0][r] = v; mx = fmaxf(mx, v); }
#pragma unroll
        for (int kt = 1; kt < 4; ++kt)
#pragma unroll
            for (int r = 0; r < 16; ++r) mx = fmaxf(mx, s[kt][r]);
#pragma unroll
        for (int r = 0; r < 16; ++r) { const float v = (u <= -crow(r, 0)) ? s[4][r] : -1.0e30f; s[4][r] = v; mx = fmaxf(mx, v); }
    } else {
#pragma unroll
        for (int kt = 0; kt < 5; ++kt)
#pragma unroll
            for (int r = 0; r < 16; ++r) {
                const int key = R0 - 64 + 32 * kt + crow(r, hh); const int dd = key - qrow;
                const bool valid = key >= lo && key < hi && dd <= 64 && dd >= -64;
                const float v = valid ? s[kt][r] : -1.0e30f; s[kt][r] = v; mx = fmaxf(mx, v);
            }
    }
    mx = fmaxf(mx, __shfl_xor(mx, 32));
    float sum = 0.f;
#pragma unroll
    for (int kt = 0; kt < 5; ++kt)
#pragma unroll
        for (int r = 0; r < 16; ++r) { const float e = __builtin_amdgcn_exp2f(s[kt][r] - mx); s[kt][r] = e; sum += e; }
    sum += __shfl_xor(sum, 32);
    f32x16 o[2];
#pragma unroll
    for (int i = 0; i < 16; ++i) { o[0][i] = 0.f; o[1][i] = 0.f; }
#pragma unroll
    for (int kt = 0; kt < 5; ++kt)
#pragma unroll
        for (int s2 = 0; s2 < 2; ++s2) {
            u32x4 pw;
            pw.x = pk_bf16_nop(s[kt][8 * s2 + 0], s[kt][8 * s2 + 1]); pw.y = pk_bf16_nop(s[kt][8 * s2 + 2], s[kt][8 * s2 + 3]);
            pw.z = pk_bf16_nop(s[kt][8 * s2 + 4], s[kt][8 * s2 + 5]); pw.w = pk_bf16_nop(s[kt][8 * s2 + 6], s[kt][8 * s2 + 7]);
            const bf16x8 pf = __builtin_bit_cast(bf16x8, pw);
            const int tq4 = (lane >> 2) & 3, tp4 = lane & 3, r0k = kl0 + 32 * kt + 16 * s2 + 4 * hh + tq4;
#pragma unroll
            for (int dt = 0; dt < 2; ++dt) {
                const int ch = 4 * dt + 2 * ((lane >> 4) & 1) + (tp4 >> 1);
                const u32x2 a = tr_read(lds + AK_BYTES + vswz_a(r0k, ch) + 8 * (tp4 & 1)), b = tr_read(lds + AK_BYTES + vswz_a(r0k + 8, ch) + 8 * (tp4 & 1));
                u32x4 vw; vw.x = a.x; vw.y = a.y; vw.z = b.x; vw.w = b.y;
                o[dt] = MFMA32(__builtin_bit_cast(bf16x8, vw), pf, o[dt]);
            }
        }
    const int lgL = (S == S0 ? 14 : 13) - sh, offq = qrow - base, rr = offq >> lgL, mm = offq - (rr << lgL), token = base + (mm << sh) + rr;
    const float inv = 1.0f / sum, lse = mx + __log2f(sum);
    if (!MERGE) {
        bf16_t* og = (bf16_t*)(p.x) + (size_t)(g - 1) * MTOK * 512 + (size_t)token * 512 + head * 64 + 4 * hh;
        float* lg = (float*)(p.ws + OFF_LSE) + (size_t)(g - 1) * MTOK * 8;
#pragma unroll
        for (int dt = 0; dt < 2; ++dt)
#pragma unroll
            for (int a = 0; a < 4; ++a) { u32x2 wv; wv.x = pk_bf16(o[dt][4 * a] * inv, o[dt][4 * a + 1] * inv); wv.y = pk_bf16(o[dt][4 * a + 2] * inv, o[dt][4 * a + 3] * inv);
                *(u32x2*)(og + 32 * dt + 8 * a) = wv; }
        if (hh == 0) lg[(size_t)token * 8 + head] = lse;
    } else {
        const float* lg = (const float*)(p.ws + OFF_LSE);
        const float l1 = lg[(size_t)token * 8 + head], l2 = lg[(size_t)MTOK * 8 + (size_t)token * 8 + head];
        const float m3 = fmaxf(lse, fmaxf(l1, l2));
        float w0 = __builtin_amdgcn_exp2f(lse - m3), w1 = __builtin_amdgcn_exp2f(l1 - m3), w2 = __builtin_amdgcn_exp2f(l2 - m3);
        const float wi = 1.0f / (w0 + w1 + w2); w0 *= wi * inv; w1 *= wi; w2 *= wi;
        const bf16_t* o1 = (const bf16_t*)(p.x) + (size_t)token * 512 + head * 64 + 4 * hh;
        const bf16_t* o2 = o1 + (size_t)MTOK * 512;
        bf16_t* of = (bf16_t*)(p.ws + OFF_BIG + 80 * MiB) + (size_t)token * 512 + head * 64 + 4 * hh;
#pragma unroll
        for (int dt = 0; dt < 2; ++dt)
#pragma unroll
            for (int a = 0; a < 4; ++a) {
                const u32x2 x1 = *(const u32x2*)(o1 + 32 * dt + 8 * a), x2 = *(const u32x2*)(o2 + 32 * dt + 8 * a);
                const float r0 = o[dt][4 * a] * w0 + bf_lo(x1.x) * w1 + bf_lo(x2.x) * w2, r1 = o[dt][4 * a + 1] * w0 + bf_hi(x1.x) * w1 + bf_hi(x2.x) * w2;
                const float r2 = o[dt][4 * a + 2] * w0 + bf_lo(x1.y) * w1 + bf_lo(x2.y) * w2, r3 = o[dt][4 * a + 3] * w0 + bf_hi(x1.y) * w1 + bf_hi(x2.y) * w2;
                u32x2 wv; wv.x = pk_bf16(r0, r1); wv.y = pk_bf16(r2, r3);
                *(u32x2*)(of + 32 * dt + 8 * a) = wv;
            }
    }
}

DI void attn_items(int vb, int nitems, int& it0, int& step, int& end) { const int G = (int)gridDim.x; if ((G & 7) || (nitems % G)) { it0 = vb; step = G; end = nitems; } else { it0 = (vb & 7) * (nitems >> 3) + (vb >> 3); step = G >> 3; end = it0 + (nitems / G) * step; } }
template <bool MERGE>
__device__ __forceinline__ void attn_a_phase(const Params& p, LAS unsigned char* lds, int g_lo, int n_g, int vb) {
    int tid = threadIdx.x; asm volatile("" : "+v"(tid));
    const int lane = tid & 63, w = __builtin_amdgcn_readfirstlane(tid >> 6);
    const int nitems = n_g * 8 * 320;
    u32x4 kr[6], vr[6]; bf16x8 qf[4], qn[4];
    int it, itstep, itend; attn_items(vb, nitems, it, itstep, itend);
    if (it < itend) { attn_a_prefetch(p, g_lo + it / 2560, (it % 2560) / 320, it % 320, tid, kr, vr); attn_a_qload(p, g_lo + it / 2560, (it % 2560) / 320, it % 320, w, lane, qf); }
    for (; it < itend; it += itstep) {
        __syncthreads();
        attn_a_stage(lds, tid, kr, vr);
        __syncthreads();
        const int nx = it + itstep;
        if (nx < itend) { attn_a_prefetch(p, g_lo + nx / 2560, (nx % 2560) / 320, nx % 320, tid, kr, vr); attn_a_qload(p, g_lo + nx / 2560, (nx % 2560) / 320, nx % 320, w, lane, qn); }
        attn_a_compute<MERGE>(p, lds, g_lo + it / 2560, (it % 2560) / 320, it % 320, w, lane, qf);
        if (nx < itend) {
#pragma unroll
            for (int kk = 0; kk < 4; ++kk) qf[kk] = qn[kk]; }
    }
    __syncthreads();
}

DI void attn_b_geom(int rp, int& base, int& rows, int& r0, int& krow0) {
    const int T0 = rp * 128; int S; seq_of(T0, base, S); rows = S >> 6; r0 = (T0 - base) >> 6;
    int rs = r0 - 4; rs = rs < 0 ? 0 : (rs > rows - 8 ? rows - 8 : rs); krow0 = rs;
}
DI void attn_b_qload(const Params& p, int head, int rp, int w, int lane, bf16x8 (&qf)[2]) {
    const bf16_t* Qb = (const bf16_t*)(p.ws + OFF_BIG);
    const int T0 = rp * 128 + 16 * w, q = lane & 15, qq = lane >> 4;
#pragma unroll
    for (int kk = 0; kk < 2; ++kk) qf[kk] = *(const bf16x8*)(Qb + (size_t)(T0 + q) * 1024 + head * 64 + 32 * kk + 8 * qq);
}
DI void attn_b_prefetch(const Params& p, int head, int rp, int tid, u32x4 (&kr)[9], u32x4 (&vr)[9]) {
    const bf16_t* Kb = (const bf16_t*)(p.ws + OFF_BIG + 160 * MiB) + head * 64;
    const bf16_t* Vb = (const bf16_t*)(p.ws + OFF_BIG + 320 * MiB) + head * 64;
    int base, rows, r0, krow0; attn_b_geom(rp, base, rows, r0, krow0);
#pragma unroll
    for (int i = 0; i < 9; ++i) { const int c = tid + 512 * i, kl = c >> 3, ch = c & 7; int gr = krow0 + (kl >> 6); gr = gr > rows - 1 ? rows - 1 : gr;
        const size_t o = (size_t)(base + gr * 64 + (kl & 63)) * 1024 + ch * 8;
        kr[i] = *(const u32x4*)(Kb + o); vr[i] = *(const u32x4*)(Vb + o); }
}
DI void attn_b_stage(LAS unsigned char* lds, int tid, const u32x4 (&kr)[9], const u32x4 (&vr)[9]) {
#pragma unroll
    for (int i = 0; i < 9; ++i) { const int c = tid + 512 * i, kl = c >> 3, ch = c & 7; *(LAS u32x4*)(lds + kswz(kl, ch)) = kr[i]; *(LAS u32x4*)(lds + BK_BYTES + vswz_b(kl, ch)) = vr[i]; }
}
__device__ __forceinline__ void attn_b_compute(const Params& p, const LAS unsigned char* lds, int head, int rp, int w, int lane, const bf16x8 (&qf)[2]) {
    bf16_t* Ob = (bf16_t*)(p.ws + OFF_BIG + 480 * MiB);
    const LAS float* rb = (const LAS float*)(lds + B_RPB_OFF);
    int base, rows, r0, krow0; attn_b_geom(rp, base, rows, r0, krow0);
    const int q = lane & 15, qq = lane >> 4;
    const int r = r0 + (w >> 2), c0 = 16 * (w & 3), T0 = base + r * 64 + c0;
    int rs = r - 4; rs = rs < 0 ? 0 : (rs > rows - 8 ? rows - 8 : rs);
    const int jl0 = rs - krow0;
    int kc0 = c0 - 8; kc0 = kc0 < 0 ? 0 : (kc0 > 32 ? 32 : kc0);
    const int c = c0 + q; int cs = c - 8; cs = cs < 0 ? 0 : (cs > 48 ? 48 : cs);
    f32x4 s[8][2];
#pragma unroll
    for (int j = 0; j < 8; ++j)
#pragma unroll
        for (int ct = 0; ct < 2; ++ct) {
            const int kl = (jl0 + j) * 64 + kc0 + 16 * ct + q;
            const bf16x8 k0 = *(const LAS bf16x8*)(lds + kswz(kl, qq)), k1 = *(const LAS bf16x8*)(lds + kswz(kl, 4 + qq));
            f32x4 z = (f32x4){0.f, 0.f, 0.f, 0.f};
            z = MFMA16(k0, qf[0], z); z = MFMA16(k1, qf[1], z);
            s[j][ct] = z;
        }
    float mx = -3.0e38f;
    const int uu = kc0 + 4 * qq - cs;
    const LAS float* rbl = rb + ((rs - r + 7) * 31 + (kc0 + 4 * qq - c + 15));
#pragma unroll
    for (int j = 0; j < 8; ++j)
#pragma unroll
        for (int ct = 0; ct < 2; ++ct)
#pragma unroll
            for (int e = 0; e < 4; ++e) {
                const bool valid = (unsigned)(uu + 16 * ct + e) < 16u;
                const float v = valid ? s[j][ct][e] + rbl[31 * j + 16 * ct + e] : -1.0e30f; s[j][ct][e] = v; mx = fmaxf(mx, v);
            }
    mx = fmaxf(mx, __shfl_xor(mx, 16)); mx = fmaxf(mx, __shfl_xor(mx, 32));
    float sum = 0.f;
#pragma unroll
    for (int j = 0; j < 8; ++j)
#pragma unroll
        for (int ct = 0; ct < 2; ++ct)
#pragma unroll
            for (int e = 0; e < 4; ++e) { const float ex = __builtin_amdgcn_exp2f(s[j][ct][e] - mx); s[j][ct][e] = ex; sum += ex; }
    sum += __shfl_xor(sum, 16); sum += __shfl_xor(sum, 32);
    f32x4 o[4];
#pragma unroll
    for (int dt = 0; dt < 4; ++dt) o[dt] = (f32x4){0.f, 0.f, 0.f, 0.f};
#pragma unroll
    for (int j = 0; j < 8; ++j) {
        u32x4 pw; pw.x = pk_bf16_nop(s[j][0][0], s[j][0][1]); pw.y = pk_bf16_nop(s[j][0][2], s[j][0][3]); pw.z = pk_bf16_nop(s[j][1][0], s[j][1][1]); pw.w = pk_bf16_nop(s[j][1][2], s[j][1][3]);
        const bf16x8 pf = __builtin_bit_cast(bf16x8, pw);
        const int tq4 = (lane >> 2) & 3, tp4 = lane & 3, r0k = (jl0 + j) * 64 + kc0 + 4 * qq + tq4;
#pragma unroll
        for (int dt = 0; dt < 4; ++dt) {
            const int ch = 2 * dt + (tp4 >> 1);
            const u32x2 a = tr_read(lds + BK_BYTES + vswz_b(r0k, ch) + 8 * (tp4 & 1)), b = tr_read(lds + BK_BYTES + vswz_b(r0k + 16, ch) + 8 * (tp4 & 1));
            u32x4 vw; vw.x = a.x; vw.y = a.y; vw.z = b.x; vw.w = b.y;
            o[dt] = MFMA16(__builtin_bit_cast(bf16x8, vw), pf, o[dt]);
        }
    }
    const float inv = 1.0f / sum;
    bf16_t* op = Ob + (size_t)(T0 + q) * 1024 + head * 64 + 4 * qq;
#pragma unroll
    for (int dt = 0; dt < 4; ++dt) { u32x2 wv; wv.x = pk_bf16(o[dt].x * inv, o[dt].y * inv); wv.y = pk_bf16(o[dt].z * inv, o[dt].w * inv); *(u32x2*)(op + 16 * dt) = wv; }
}
__device__ __forceinline__ void attn_b_phase(const Params& p, LAS unsigned char* lds, int vb) {
    int tid = threadIdx.x; asm volatile("" : "+v"(tid));
    const int lane = tid & 63, w = __builtin_amdgcn_readfirstlane(tid >> 6);
    const int nitems = 16 * 640;
    u32x4 kr[9], vr[9]; bf16x8 qf[2], qn[2];
    int it, itstep, itend; attn_items(vb, nitems, it, itstep, itend);
    if (it < itend) { attn_b_prefetch(p, it / 640, it % 640, tid, kr, vr); attn_b_qload(p, it / 640, it % 640, w, lane, qf); }
    for (; it < itend; it += itstep) {
        const int head = it / 640;
        __syncthreads();
        attn_b_stage(lds, tid, kr, vr);
        if (tid < 465) ((LAS float*)(lds + B_RPB_OFF))[tid] = p.in[16][head * 465 + tid] * 1.4426950408889634f;
        __syncthreads();
        const int nx = it + itstep;
        if (nx < itend) { attn_b_prefetch(p, nx / 640, nx % 640, tid, kr, vr); attn_b_qload(p, nx / 640, nx % 640, w, lane, qn); }
        attn_b_compute(p, lds, head, it % 640, w, lane, qf);
        if (nx < itend) { qf[0] = qn[0]; qf[1] = qn[1]; }
    }
    __syncthreads();
}


#define XB_TMO      128
#define XB_XCNT(j)  (256  + 64 * (j))
#define XB_XSUB(j)  (1280 + 64 * (j))
#define XB_XGEN(j)  (2304 + 64 * (j))
#define XB_TOP      3328
#define XB_TOPGEN   3392
#define XCD_BAR_WORDS 3456
#define XB_SPIN_CAP (1u << 18)
__device__ __forceinline__ unsigned xb_ld(unsigned* p)              { return __hip_atomic_load(p, __ATOMIC_RELAXED, __HIP_MEMORY_SCOPE_AGENT); }
__device__ __forceinline__ unsigned xb_add(unsigned* p, unsigned v) { return __hip_atomic_fetch_add(p, v, __ATOMIC_RELAXED, __HIP_MEMORY_SCOPE_AGENT); }
__device__ __forceinline__ unsigned xb_xcc_id() { return (unsigned)__builtin_amdgcn_s_getreg((3 << 11) | 20) & 0xFu; }
#define XB_SPIN(cond, bar) do { unsigned _sp = 0; while (cond) { __builtin_amdgcn_s_sleep(1); \
    if ((++_sp & 255u) == 0u) { if (xb_ld(&(bar)[XB_TMO])) break; if (_sp > XB_SPIN_CAP) { atomicAdd(&(bar)[XB_TMO], 1u); break; } } } } while (0)
struct XcdBarrier { unsigned* bar; unsigned x; volatile LAS unsigned* st; };
__device__ __forceinline__ XcdBarrier xcd_barrier_post(unsigned* bar, volatile LAS unsigned* st) {
    XcdBarrier b; b.bar = bar; b.x = xb_xcc_id(); b.st = st;
    if (threadIdx.x == 0) st[2] = xb_add(&bar[XB_XCNT(b.x)], 1u);
    return b;
}
__device__ __forceinline__ void xcd_barrier_complete(unsigned* bar, unsigned x, unsigned& nloc, unsigned& nx) {
    const unsigned G = gridDim.x * gridDim.y * gridDim.z;
    unsigned sum, cnt, mine, sp = 0u;
    for (;;) {
        sum = 0u; cnt = 0u; mine = 0u;
#pragma unroll
        for (unsigned j = 0; j < 16; ++j) { const unsigned c = xb_ld(&bar[XB_XCNT(j)]); sum += c; cnt += (c > 0u) ? 1u : 0u; mine = (j == x) ? c : mine; }
        if (sum == G) break;
        __builtin_amdgcn_s_sleep(1);
        if ((++sp & 255u) == 0u) { if (xb_ld(&bar[XB_TMO])) break; if (sp > XB_SPIN_CAP) { atomicAdd(&bar[XB_TMO], 1u); break; } }
    }
    nloc = mine > 0u ? mine : 1u; nx = cnt > 0u ? cnt : 1u;
}
__device__ __forceinline__ void xcd_barrier(const XcdBarrier& b) {
    asm volatile("s_waitcnt vmcnt(0)" ::: "memory");
    __syncthreads();
    if (threadIdx.x == 0) {
        unsigned* bar = b.bar;
        __builtin_amdgcn_s_waitcnt(0);
        unsigned nloc = b.st[0], nx = b.st[1];
        if (nloc == 0u) { xcd_barrier_complete(bar, b.x, nloc, nx); b.st[0] = nloc; b.st[1] = nx; }
        const unsigned old = xb_add(&bar[XB_XSUB(b.x)], 1u);
        const unsigned gen = old / nloc;
        if (old + 1u == (gen + 1u) * nloc) {
            __builtin_amdgcn_fence(__ATOMIC_RELEASE, "agent");
            asm volatile("s_waitcnt vmcnt(0)" ::: "memory");
            const unsigned og = xb_add(&bar[XB_TOP], 1u);
            const unsigned tg = og / nx;
            if (og + 1u == (tg + 1u) * nx) xb_add(&bar[XB_TOPGEN], 1u);
            else XB_SPIN(xb_ld(&bar[XB_TOPGEN]) == tg, bar);
            __builtin_amdgcn_fence(__ATOMIC_ACQUIRE, "agent");
            xb_add(&bar[XB_XGEN(b.x)], 1u);
            asm volatile("s_waitcnt vmcnt(0)" ::: "memory");
        } else {
            XB_SPIN(xb_ld(&bar[XB_XGEN(b.x)]) == gen, bar);
            __builtin_amdgcn_fence(__ATOMIC_ACQUIRE, "agent");
            asm volatile("s_waitcnt vmcnt(0)" ::: "memory");
        }
    }
    __syncthreads();
}

__global__ void __launch_bounds__(512, 2) mega_kernel(Params p) {
    extern __shared__ __attribute__((aligned(16))) unsigned char shm[];
    LAS unsigned char* lds = (LAS unsigned char*)shm;
    cg::grid_group grid = cg::this_grid();
    bf16_t* WB = (bf16_t*)(p.ws + OFF_WB);
    bf16_t* xb = (bf16_t*)(p.ws + OFF_XB);
    float* ssq = (float*)(p.ws + OFF_SSQ);
    bf16_t* hbuf = (bf16_t*)(p.ws + OFF_BIG);
    const float* cosT = (const float*)(p.ws + OFF_COS); const float* sinT = (const float*)(p.ws + OFF_SIN);

    volatile LAS unsigned* xst = (volatile LAS unsigned*)(lds + XB_LDS_OFF);
    if (threadIdx.x == 0) { xst[0] = 0u; xst[1] = 0u; xst[2] = 0u; xst[3] = 0u; }
    __syncthreads();
    const XcdBarrier xbar = xcd_barrier_post((unsigned*)(p.ws + OFF_BAR), xst);
    for (int rep = 0; rep < REP_PREP; ++rep) phase_prep(p, lds);
    grid.sync();
    if (threadIdx.x == 0) {
        unsigned* bar = (unsigned*)(p.ws + OFF_BAR); bool ok = (gridDim.x % 8u) == 0u;
        for (unsigned j = 0; j < 16; ++j) { const unsigned cnt = xb_ld(&bar[XB_XCNT(j)]); if (j < 8 ? cnt != gridDim.x / 8u : cnt != 0u) ok = false; }
        xst[3] = ok ? xst[2] * 8u + xbar.x : blockIdx.x;
    }
    __syncthreads();
#define VB() __builtin_amdgcn_readfirstlane((int)xst[3])

    for (int step = 0; step < 4; ++step) {
        const int layer = step >> 1;
        if (step & 1) {
            if (layer == 0) {
                { EpiQkv<true> E; E.A = xb; E.ssq = ssq; E.qgain = p.in[10]; E.kgain = p.in[11]; E.cosT = cosT; E.sinT = sinT;
                  E.Q = (bf16_t*)(p.ws + OFF_BIG); E.Kk = (bf16_t*)(p.ws + OFF_BIG + 240 * MiB); E.VT = (bf16_t*)(p.ws + OFF_BIG + 480 * MiB);
                  for (int rep = 0; rep < REP_QKV; ++rep) gemm_phase<4608, 1024>(lds, WB + W_AQKV, E, 0, VB()); }
                xcd_barrier(xbar);
                for (int rep = 0; rep < REP_ATT; ++rep) attn_a_phase<false>(p, lds, 1, 2, VB());
                xcd_barrier(xbar);
                for (int rep = 0; rep < REP_ATT; ++rep) attn_a_phase<true>(p, lds, 0, 1, VB());
                xcd_barrier(xbar);
                { EpiResid E; E.A = (const bf16_t*)(p.ws + OFF_BIG + 80 * MiB); E.K = 512; E.blocked = 0; E.xout = p.x; E.xb = xb; E.ssq = ssq; E.alpha = 1.0f; E.final = 0;
                  gemm_phase<1024, 512>(lds, WB + W_AWO, E, 1, VB()); }
                xcd_barrier(xbar);
            } else {
                { EpiQkv<false> E; E.A = xb; E.ssq = ssq; E.qgain = p.in[14]; E.kgain = p.in[15]; E.cosT = cosT; E.sinT = sinT;
                  E.Q = (bf16_t*)(p.ws + OFF_BIG); E.Kk = (bf16_t*)(p.ws + OFF_BIG + 160 * MiB); E.VT = (bf16_t*)(p.ws + OFF_BIG + 320 * MiB);
                  for (int rep = 0; rep < REP_QKV; ++rep) gemm_phase<3072, 1024>(lds, WB + W_BQKV, E, 0, VB()); }
                xcd_barrier(xbar);
                for (int rep = 0; rep < REP_ATT; ++rep) attn_b_phase(p, lds, VB());
                xcd_barrier(xbar);
                { EpiResid E; E.A = (const bf16_t*)(p.ws + OFF_BIG + 480 * MiB); E.K = 1024; E.blocked = 0; E.xout = p.x; E.xb = xb; E.ssq = ssq; E.alpha = 1.0f; E.final = 0;
                  gemm_phase<1024, 1024>(lds, WB + W_BWO, E, 1, VB()); }
                xcd_barrier(xbar);
            }
        }
        for (int rep = 0; rep < REP_SWI; ++rep) { EpiSwiglu E; E.A = xb; E.H = hbuf; E.ssq = ssq; gemm_phase<5632, 1024>(lds, WB + W_IN0 + (size_t)step * WIN_SZ, E, 0, VB()); }
        xcd_barrier(xbar);
        for (int rep = 0; rep < REP_FOUT; ++rep) { EpiResid E; E.A = hbuf; E.K = DFF; E.blocked = 1; E.xout = p.x; E.xb = xb; E.ssq = ssq; E.alpha = (rep == REP_FOUT - 1) ? 0.5f : 0.0f; E.final = (step == 3 && rep == REP_FOUT - 1) ? 1 : 0; gemm_phase<1024, DFF>(lds, WB + W_OUT0 + (size_t)step * WOUT_SZ, E, 1, VB()); }
        if (step < 3) xcd_barrier(xbar);
    }
}

extern "C" void kernel_launch(void* const* d_in, const int* in_sizes, int n_in, void* d_out, int out_size, void* d_ws, size_t ws_size, hipStream_t stream) {
    static int grid_blocks = 0;
    if (!grid_blocks) {
        hipFuncSetAttribute((const void*)mega_kernel, hipFuncAttributeMaxDynamicSharedMemorySize, LDS_BYTES);
        int dev = 0, cus = 0, per_cu = 0;
        hipGetDevice(&dev);
        hipDeviceGetAttribute(&cus, hipDeviceAttributeMultiprocessorCount, dev);
        hipOccupancyMaxActiveBlocksPerMultiprocessor(&per_cu, mega_kernel, 512, LDS_BYTES);
        if (per_cu < 1) per_cu = 1;
        grid_blocks = cus;
    }
    Params p{};
    for (int i = 0; i < 18; ++i) p.in[i] = (const float*)d_in[i];
    p.x = (float*)d_out;
    p.ws = (unsigned char*)d_ws;
    hipMemsetAsync((unsigned char*)d_ws + OFF_BAR, 0, XCD_BAR_WORDS * sizeof(unsigned), stream);
    void* args[] = {&p};
    hipError_t e = hipLaunchCooperativeKernel((void*)mega_kernel, dim3(grid_blocks), dim3(512), args, LDS_BYTES, stream);
    if (e != hipSuccess) fprintf(stderr, "cooperative launch failed: %s (grid %d)\n", hipGetErrorString(e), grid_blocks);
}
```
